# Optimizing an MI355X kernel written in HIP

```python
import math
import jax, jax.numpy as jnp
from jax import lax
import numpy as np

D_MODEL = 1024
BATCH = 8
SEQ = 8192
DEPTH = 1
DEC_BATCH = 8
DEC_SEQ = 64
PAST_LEN = 4096

CHUNK = 64
BAND_CHUNKS = 8
BAND_ROWS = BAND_CHUNKS * CHUNK
D_RNN = D_MODEL
N_LRU_BLOCKS = 8
LRU_BLOCK = D_RNN // N_LRU_BLOCKS
CONV_W = 4
LRU_C = 8.0
N_HEADS = 8
HEAD_DIM = D_MODEL // N_HEADS
D_ATT = N_HEADS * HEAD_DIM
MAX_REL = 128
ATT_SCALE = HEAD_DIM ** -0.5
NEG_INF = -1e30
D_FF = 4 * D_MODEL
ALPHA = (2 * DEPTH) ** 0.25
BETA = (8 * DEPTH) ** -0.25
LN_EPS = 1e-5
D_IN = 2 * D_RNN + 3 * D_ATT + 2 * D_MODEL
IN_SPLITS = (D_RNN, 2 * D_RNN, 2 * D_RNN + D_ATT, 2 * D_RNN + 2 * D_ATT, 2 * D_RNN + 3 * D_ATT, 2 * D_RNN + 3 * D_ATT + D_MODEL)

kernel_name = 'hawk_chunkband_deepnorm_adaln_step'


def _ln(x, g, b):
    xf = x.astype(jnp.float32)
    mu = jnp.mean(xf, axis=-1, keepdims=True)
    xc = xf - mu
    var = jnp.mean(jnp.square(xc), axis=-1, keepdims=True)
    y = xc * lax.rsqrt(var + LN_EPS) * g.astype(jnp.float32) + b.astype(jnp.float32)
    return y.astype(x.dtype)


def _causal_conv(xr, hist, w, b):
    t = xr.shape[1]
    xp = jnp.concatenate([hist.astype(xr.dtype), xr], axis=1)
    y = b + xp[:, 0:t] * w[0]
    for j in range(1, CONV_W):
        y = y + xp[:, j:j + t] * w[j]
    return y, xp[:, -(CONV_W - 1):]


def _lin_comb(e1, e2):
    a1, b1 = e1
    a2, b2 = e2
    return a1 * a2, a2 * b1 + b2


def _rg_lru(xc, h0, w_rg, b_rg, w_ig, b_ig, lam, reset_first):
    bsz, t, _ = xc.shape
    f32 = jnp.float32
    xf = xc.astype(f32)
    xb = xf.reshape(bsz, t, N_LRU_BLOCKS, LRU_BLOCK)
    r = jax.nn.sigmoid(jnp.einsum('btnc,ncd->btnd', xb, w_rg.astype(f32)) + b_rg.astype(f32)).reshape(bsz, t, D_RNN)
    i = jax.nn.sigmoid(jnp.einsum('btnc,ncd->btnd', xb, w_ig.astype(f32)) + b_ig.astype(f32)).reshape(bsz, t, D_RNN)
    log_a = -LRU_C * r * jax.nn.softplus(-lam.astype(f32))
    a = jnp.exp(log_a)
    mult = jnp.sqrt(-jnp.expm1(2.0 * log_a))
    if reset_first:
        mult = mult.at[:, 0].set(1.0)
        a = a.at[:, 0].set(0.0)
    bterm = mult * (i * xf)
    bterm = bterm.at[:, 0].add(a[:, 0] * h0.astype(f32))
    _, h = lax.associative_scan(_lin_comb, (a, bterm), axis=1)
    return h, h[:, -1]


def _rel_bias(table, rel):
    return table[:, jnp.clip(rel, -MAX_REL, MAX_REL) + MAX_REL].astype(jnp.float32)


def _attend(q, k, v, bias, valid):
    s = jnp.einsum('bqhd,bkhd->bhqk', q, k).astype(jnp.float32) * ATT_SCALE + bias
    if valid is not None:
        s = jnp.where(valid, s, NEG_INF)
    p = jax.nn.softmax(s, axis=-1)
    return jnp.einsum('bhqk,bkhd->bqhd', p.astype(v.dtype), v)


def _prompt_band_attn(q, k, v, table):
    bsz, t = q.shape[0], q.shape[1]
    n_chunks = t // CHUNK
    pad = ((0, 0), (BAND_ROWS, 0), (0, 0), (0, 0))
    kp = jnp.pad(k, pad)
    vp = jnp.pad(v, pad)
    qi = jnp.arange(CHUNK)
    ki = jnp.arange(BAND_ROWS + CHUNK)
    bias = _rel_bias(table, qi[:, None] + BAND_ROWS - ki[None, :])

    def one_chunk(j):
        start = j * CHUNK
        qj = lax.dynamic_slice_in_dim(q, start, CHUNK, axis=1)
        kj = lax.dynamic_slice_in_dim(kp, start, BAND_ROWS + CHUNK, axis=1)
        vj = lax.dynamic_slice_in_dim(vp, start, BAND_ROWS + CHUNK, axis=1)
        valid = (ki >= BAND_ROWS - start)[None, :]
        return _attend(qj, kj, vj, bias, valid)

    o = lax.map(one_chunk, jnp.arange(n_chunks))
    o = jnp.moveaxis(o, 0, 1).reshape(bsz, t, D_ATT)
    rows = min(BAND_ROWS, t)
    return o, k[:, t - rows:], v[:, t - rows:]


def _sample_band_attn(q, k, v, k_past, v_past, table):
    bsz, s = q.shape[0], q.shape[1]
    n_past = k_past.shape[1]
    kk = jnp.concatenate([k_past.astype(k.dtype), k], axis=1)
    vv = jnp.concatenate([v_past.astype(v.dtype), v], axis=1)
    kpos = jnp.arange(n_past + s) - n_past
    bias = _rel_bias(table, jnp.arange(s)[:, None] - kpos[None, :])
    o = _attend(q, kk, vv, bias, None)
    return o.reshape(bsz, s, D_ATT), k, v


def _layer(x, c, conv_hist, h0, k_past, v_past, reset_first, w):
    bsz, t, _ = x.shape
    mod = jax.nn.silu(c) @ w['w_ada'] + w['b_ada']
    sh1, sc1, g1, sh2, sc2, g2 = jnp.split(mod[:, None, :], 6, axis=-1)
    u = x * (1.0 + sc1) + sh1
    xr, gl, q, k, v, ga, gb = jnp.split(u @ w['w_in'], IN_SPLITS, axis=-1)
    xc, conv_new = _causal_conv(xr, conv_hist, w['conv_w'], w['conv_b'])
    h, h_last = _rg_lru(xc, h0, w['w_rg'], w['b_rg'], w['w_ig'], w['b_ig'], w['lru_lambda'], reset_first)
    y_a = h.astype(x.dtype) * jax.nn.gelu(gl)
    heads = (bsz, t, N_HEADS, HEAD_DIM)
    q, k, v = q.reshape(heads), k.reshape(heads), v.reshape(heads)
    if k_past is None:
        y_b, k_new, v_new = _prompt_band_attn(q, k, v, w['rel_bias'])
    else:
        y_b, k_new, v_new = _sample_band_attn(q, k, v, k_past, v_past, w['rel_bias'])
    merged = jax.nn.sigmoid(ga) * y_a + jax.nn.sigmoid(gb) * y_b
    x1 = _ln(ALPHA * x + (1.0 + g1) * (merged @ w['w_out']), w['ln1_g'], w['ln1_b'])
    u2 = x1 * (1.0 + sc2) + sh2
    f = jnp.square(jax.nn.relu(u2 @ w['w_up'] + w['b_up'])) @ w['w_down'] + w['b_down']
    y = _ln(ALPHA * x1 + (1.0 + g2) * f, w['ln2_g'], w['ln2_b'])
    return y, k_new, v_new, conv_new, h_last.astype(x.dtype)


def setup_inputs(seed: int = 0) -> dict:
    key = jax.random.key(seed)
    ks = jax.random.split(key, 32)

    def nrm(k, shape, s):
        return s * jax.random.normal(k, shape, jnp.float32)

    L = DEPTH
    cache_rows = min(BAND_ROWS, PAST_LEN)
    a0 = jax.random.uniform(ks[31], (L, D_RNN), jnp.float32, minval=0.9, maxval=0.999)
    return {
        'x_prompt': nrm(ks[0], (BATCH, SEQ, D_MODEL), 1.0),
        'x_sample': nrm(ks[1], (DEC_BATCH, DEC_SEQ, D_MODEL), 1.0),
        'c_prompt': nrm(ks[2], (BATCH, D_MODEL), 1.0),
        'c_sample': nrm(ks[3], (DEC_BATCH, D_MODEL), 1.0),
        'cache_k': nrm(ks[4], (L, DEC_BATCH, cache_rows, N_HEADS, HEAD_DIM), 1.0),
        'cache_v': nrm(ks[5], (L, DEC_BATCH, cache_rows, N_HEADS, HEAD_DIM), 1.0),
        'state_conv': nrm(ks[6], (L, DEC_BATCH, CONV_W - 1, D_RNN), 1.0),
        'state_lru': nrm(ks[7], (L, DEC_BATCH, D_RNN), 0.3),
        'w_ada': nrm(ks[8], (L, D_MODEL, 6 * D_MODEL), 0.1 * D_MODEL ** -0.5),
        'b_ada': nrm(ks[9], (L, 6 * D_MODEL), 0.01),
        'w_in': nrm(ks[10], (L, D_MODEL, D_IN), D_MODEL ** -0.5),
        'conv_w': nrm(ks[11], (L, CONV_W, D_RNN), CONV_W ** -0.5),
        'conv_b': nrm(ks[12], (L, D_RNN), 0.01),
        'w_rg': nrm(ks[13], (L, N_LRU_BLOCKS, LRU_BLOCK, LRU_BLOCK), LRU_BLOCK ** -0.5),
        'b_rg': nrm(ks[14], (L, N_LRU_BLOCKS, LRU_BLOCK), 0.01),
        'w_ig': nrm(ks[15], (L, N_LRU_BLOCKS, LRU_BLOCK, LRU_BLOCK), LRU_BLOCK ** -0.5),
        'b_ig': nrm(ks[16], (L, N_LRU_BLOCKS, LRU_BLOCK), 0.01),
        'lru_lambda': jnp.log(a0) - jnp.log1p(-a0),
        'rel_bias': nrm(ks[17], (L, N_HEADS, 2 * MAX_REL + 1), 0.2),
        'w_out': nrm(ks[18], (L, D_MODEL, D_MODEL), BETA * D_MODEL ** -0.5),
        'ln1_g': 1.0 + nrm(ks[19], (L, D_MODEL), 0.01),
        'ln1_b': nrm(ks[20], (L, D_MODEL), 0.01),
        'w_up': nrm(ks[21], (L, D_MODEL, D_FF), D_MODEL ** -0.5),
        'b_up': nrm(ks[22], (L, D_FF), 0.01),
        'w_down': nrm(ks[23], (L, D_FF, D_MODEL), BETA * D_FF ** -0.5),
        'b_down': nrm(ks[24], (L, D_MODEL), 0.01),
        'ln2_g': 1.0 + nrm(ks[25], (L, D_MODEL), 0.01),
        'ln2_b': nrm(ks[26], (L, D_MODEL), 0.01),
    }


def reference(x_prompt, x_sample, c_prompt, c_sample, cache_k, cache_v, state_conv, state_lru,
              w_ada, b_ada, w_in, conv_w, conv_b, w_rg, b_rg, w_ig, b_ig, lru_lambda, rel_bias,
              w_out, ln1_g, ln1_b, w_up, b_up, w_down, b_down, ln2_g, ln2_b):
    yp, ys = x_prompt, x_sample
    bp = x_prompt.shape[0]
    kp_l, vp_l, cp_l, hp_l = [], [], [], []
    ks_l, vs_l, cs_l, hs_l = [], [], [], []
    for l in range(DEPTH):
        w = {
            'w_ada': w_ada[l], 'b_ada': b_ada[l], 'w_in': w_in[l],
            'conv_w': conv_w[l], 'conv_b': conv_b[l],
            'w_rg': w_rg[l], 'b_rg': b_rg[l], 'w_ig': w_ig[l], 'b_ig': b_ig[l],
            'lru_lambda': lru_lambda[l], 'rel_bias': rel_bias[l], 'w_out': w_out[l],
            'ln1_g': ln1_g[l], 'ln1_b': ln1_b[l], 'w_up': w_up[l], 'b_up': b_up[l],
            'w_down': w_down[l], 'b_down': b_down[l], 'ln2_g': ln2_g[l], 'ln2_b': ln2_b[l],
        }
        conv0 = jnp.zeros((bp, CONV_W - 1, D_RNN), yp.dtype)
        h0 = jnp.zeros((bp, D_RNN), jnp.float32)
        yp, kp, vp, cp, hp = _layer(yp, c_prompt, conv0, h0, None, None, True, w)
        ys, ksn, vsn, csn, hsn = _layer(ys, c_sample, state_conv[l], state_lru[l], cache_k[l], cache_v[l], False, w)
        kp_l.append(kp); vp_l.append(vp); cp_l.append(cp); hp_l.append(hp)
        ks_l.append(ksn); vs_l.append(vsn); cs_l.append(csn); hs_l.append(hsn)
    return (yp, ys,
            jnp.stack(kp_l), jnp.stack(vp_l), jnp.stack(cp_l), jnp.stack(hp_l),
            jnp.stack(ks_l), jnp.stack(vs_l), jnp.stack(cs_l), jnp.stack(hs_l))
```

```cpp
#include <hip/hip_runtime.h>
#include <hip/hip_bf16.h>
#include <cstdio>
#include <cstdint>
#include <cmath>

namespace pg8 {
#define PG8_LAS __attribute__((address_space(3)))
typedef unsigned short bf16_t;
typedef short bf16x8 __attribute__((ext_vector_type(8)));
typedef float f32x4 __attribute__((ext_vector_type(4)));
typedef unsigned u32x4 __attribute__((ext_vector_type(4)));
constexpr int BM = 256, BK = 64, HALF = 128, HTB = HALF * BK * 2  , STAGE_BYTES = 8 * HTB, NXCD = 8, WGM = 8;

__host__ __device__ __forceinline__ int lds_byte(int r, int c) { const int st = (r >> 4) * 2 + (c >> 5), rr = r & 15, cc = c & 31, ob = rr * 64 + cc * 2; return st * 1024 + (ob ^ (((ob >> 9) & 1) << 5)); }
__host__ __device__ __forceinline__ void stage_rc(int b, int& R, int& C) { const int st = b / 1024, sb = b % 1024, swz = sb ^ (((sb >> 9) & 1) << 5); R = (st >> 1) * 16 + swz / 64; C = (st & 1) * 32 + (swz % 64) / 2; }
__host__ __device__ __forceinline__ int perm32(int rho) { const int n = rho >> 4, i = rho & 15; return 8 * (i >> 2) + 4 * n + (i & 3); }

struct Unit { int pm, pn; };
struct Gemm { const bf16_t* A; const bf16_t* Bt; int M, N, K; };

struct StaticOrder {
    int nM, nN, nwg, G, c;
    __host__ __device__ void init(int M, int N, int G_, int c_) { nM = M / BM; nN = N / BM; nwg = nM * nN; G = G_; c = c_; }
    __host__ __device__ bool next(int i, Unit& u) const {
        const long L = (long)i * G + c; if (L >= nwg) return false;
        int wgid = (int)L; { const int q = nwg / NXCD, r = nwg % NXCD, xcd = wgid % NXCD, off = wgid / NXCD; wgid = (xcd < r ? xcd * (q + 1) : r * (q + 1) + (xcd - r) * q) + off; }
        const int nig = WGM * nN, gid = wgid / nig, fm = gid * WGM, gsz = (nM - fm) < WGM ? (nM - fm) : WGM;
        u.pm = fm + ((wgid % nig) % gsz); u.pn = (wgid % nig) / gsz; return true;
    }
    __device__ __forceinline__ void a_ready(const Unit&) const {}
    __device__ __forceinline__ void done(const Unit&) const {}
};

__device__ __forceinline__ unsigned cvt_pk_bf16(float lo, float hi) { unsigned r; asm volatile("v_cvt_pk_bf16_f32 %0, %1, %2" : "=v"(r) : "v"(lo), "v"(hi)); return r; }
typedef float f32x2 __attribute__((ext_vector_type(2)));
__device__ __forceinline__ f32x2 gelu_pk(f32x2 v) {
    const f32x2 av = __builtin_elementwise_abs(v), d = av * 0.2316418882f + 1.0f;
    f32x2 t; t.x = __builtin_amdgcn_rcpf(d.x); t.y = __builtin_amdgcn_rcpf(d.y);
    f32x2 q = t * 0.5307027145f + (-0.7265760135f); q = q * t + 0.7107068705f; q = q * t + (-0.142248368f); q = q * t + 0.127414796f; q = q * t;
    const f32x2 s = (v * v) * (-0.72134752044f);
    f32x2 e; e.x = __builtin_amdgcn_exp2f(s.x); e.y = __builtin_amdgcn_exp2f(s.y);
    const f32x2 m = v * (q * e), r = v - m;
    f32x2 o; o.x = v.x < 0.f ? m.x : r.x; o.y = v.y < 0.f ? m.y : r.y; return o;
}

template <int ACT  > struct EpiBf16 {
    static constexpr bool PERM = true, AFTER_DRAIN = false; static_assert(ACT == 0 || ACT == 1 || ACT == 2, "EpiBf16: ACT is 0 (none), 1 (gelu_pk) or 2 (relu squared)");
    bf16_t* O; int ldc; const float* bias; int split_cols; size_t split_stride; float scale0;
    __device__ __forceinline__ void operator()(const f32x4 (&acc)[2][2][4][2], const Unit& u, int wr, int wc, int fr, int fq) const {
        const int row0 = u.pm * BM + wr * 64 + fr; int colt = u.pn * BM; bf16_t* base = O;
        float sc = 1.f; if (split_cols) { const int t = colt / split_cols; base += (size_t)t * split_stride; colt -= t * split_cols; if (t == 0) sc = scale0; }
        const int col0 = colt + wc * 32 + 8 * fq, bcol0 = u.pn * BM + wc * 32 + 8 * fq;
        f32x4 bv[2][2];
#pragma unroll
        for (int bj = 0; bj < 2; ++bj)
#pragma unroll
            for (int n = 0; n < 2; ++n) bv[bj][n] = bias ? *(const f32x4*)(bias + bcol0 + bj * HALF + 4 * n) : (f32x4){0.f, 0.f, 0.f, 0.f};
#pragma unroll
        for (int ai = 0; ai < 2; ++ai)
#pragma unroll
            for (int m = 0; m < 4; ++m) { bf16_t* rowp = base + (size_t)(row0 + ai * HALF + m * 16) * ldc + col0;
#pragma unroll
                for (int bj = 0; bj < 2; ++bj) { f32x4 v0 = acc[ai][bj][m][0] + bv[bj][0], v1 = acc[ai][bj][m][1] + bv[bj][1];
                    if (ACT == 1) { f32x2 a = gelu_pk((f32x2){v0[0], v0[1]}), b = gelu_pk((f32x2){v0[2], v0[3]}), c = gelu_pk((f32x2){v1[0], v1[1]}), d = gelu_pk((f32x2){v1[2], v1[3]});
                        v0 = (f32x4){a.x, a.y, b.x, b.y}; v1 = (f32x4){c.x, c.y, d.x, d.y}; }
                    if (ACT == 2) { _Pragma("unroll") for (int e_ = 0; e_ < 4; ++e_) { const float a_ = fmaxf(v0[e_], 0.f), b_ = fmaxf(v1[e_], 0.f); v0[e_] = a_ * a_; v1[e_] = b_ * b_; } }
                    v0 = v0 * sc; v1 = v1 * sc; u32x4 w; w.x = cvt_pk_bf16(v0[0], v0[1]); w.y = cvt_pk_bf16(v0[2], v0[3]); w.z = cvt_pk_bf16(v1[0], v1[1]); w.w = cvt_pk_bf16(v1[2], v1[3]);
                    *(u32x4*)(rowp + bj * HALF) = w; } }
    }
};


struct EpiRes {
    static constexpr bool PERM = false, AFTER_DRAIN = false;
    const float* xin_p; const float* xin_s; float* out; const float* bias; const float* mod; int goff; int mp; float alpha;
    __device__ __forceinline__ void operator()(const f32x4 (&acc)[2][2][4][2], const Unit& u, int wr, int wc, int fr, int fq) const {
        const int col0 = u.pn * BM + wc * 32 + 4 * fq;
        f32x4 bv[2][2];
#pragma unroll
        for (int bj = 0; bj < 2; ++bj)
#pragma unroll
            for (int n = 0; n < 2; ++n) bv[bj][n] = bias ? *(const f32x4*)(bias + col0 + bj * HALF + n * 16) : (f32x4){0.f, 0.f, 0.f, 0.f};
#pragma unroll
        for (int ai = 0; ai < 2; ++ai) {
            const int rowbase = u.pm * BM + ai * HALF + wr * 64;
            const int bidx = rowbase < mp ? (rowbase >> 13) : 8 + ((rowbase - mp) >> 6);
            const float* gp = mod + (size_t)bidx * 6144 + goff + col0;
            f32x4 gv[2][2];
#pragma unroll
            for (int bj = 0; bj < 2; ++bj)
#pragma unroll
                for (int n = 0; n < 2; ++n) gv[bj][n] = *(const f32x4*)(gp + bj * HALF + n * 16) + 1.0f;
#pragma unroll
            for (int m = 0; m < 4; ++m) {
                const int row = rowbase + m * 16 + fr;
                const float* xrow = (row < mp ? xin_p + (size_t)row * 1024 : xin_s + (size_t)(row - mp) * 1024) + col0;
                float* orow = out + (size_t)row * 1024 + col0;
#pragma unroll
                for (int bj = 0; bj < 2; ++bj)
#pragma unroll
                    for (int n = 0; n < 2; ++n) {
                        const f32x4 xv = *(const f32x4*)(xrow + bj * HALF + n * 16);
                        const f32x4 o = xv * alpha + gv[bj][n] * (acc[ai][bj][m][n] + bv[bj][n]);
                        *(f32x4*)(orow + bj * HALF + n * 16) = o;
                    }
                if (m & 1) asm volatile("" ::: "memory");
            }
        }
    }
};

template <class Epi, class Sched, bool ALIGN_EPI = false, bool SP2 = false>
__device__ __forceinline__ void gemm_phase(PG8_LAS unsigned char* lds, const Gemm g, const Sched& S, const Epi& E) {
    const int tid = threadIdx.x, wid = __builtin_amdgcn_readfirstlane(tid >> 6), lane = tid & 63, wr = wid >> 2, wc = wid & 3, fr = lane & 15, fq = lane >> 4;
    const int K = g.K, nt = K / BK;
    unsigned voffA[2], voffB[2];
#pragma unroll
    for (int i = 0; i < 2; ++i) { int R, C; stage_rc(tid * 16 + i * 8192, R, C); const int Rb = Epi::PERM ? ((R & ~31) + perm32(R & 31)) : R;
        voffA[i] = (unsigned)(R * K + C) * 2u; voffB[i] = (unsigned)(Rb * K + C) * 2u; }
    const size_t kstep = (size_t)(BK * 2);
    const size_t hstep = (size_t)HALF * K * 2;
    const size_t tstep = 2 * hstep;
    const unsigned ldsw = (unsigned)wid * 1024u;
    const int aoff = lds_byte(wr * 64 + fr, fq * 8), boff = lds_byte(wc * 32 + fr, fq * 8);
#define PG8_SA(b, h) (((b) * 2 + (h)) * HTB)
#define PG8_SB(b, h) ((4 + (b) * 2 + (h)) * HTB)
#define PG8_STAGE(bufoff, gbase, voff) do { _Pragma("unroll") for (int _i = 0; _i < 2; ++_i) \
        __builtin_amdgcn_global_load_lds((const unsigned*)((const char*)(gbase) + (voff)[_i]), (PG8_LAS unsigned*)(lds + (bufoff) + ldsw + _i * 8192), 16, 0, 0); } while (0)
#define PG8_LDA(dst, b, h) do { _Pragma("unroll") for (int m = 0; m < 4; ++m) _Pragma("unroll") for (int k = 0; k < 2; ++k) dst[m][k] = *(const PG8_LAS bf16x8*)(lds + PG8_SA(b, h) + aoff + m * 2048 + k * 1024); } while (0)
#define PG8_LDB(dst, b, h) do { _Pragma("unroll") for (int n = 0; n < 2; ++n) _Pragma("unroll") for (int k = 0; k < 2; ++k) dst[n][k] = *(const PG8_LAS bf16x8*)(lds + PG8_SB(b, h) + boff + n * 2048 + k * 1024); } while (0)
#define PG8_MMA(ai, bj, At, Bt) do { __builtin_amdgcn_s_setprio(1); _Pragma("unroll") for (int m = 0; m < 4; ++m) _Pragma("unroll") for (int n = 0; n < 2; ++n) _Pragma("unroll") for (int k = 0; k < 2; ++k) \
        acc[ai][bj][m][n] = __builtin_amdgcn_mfma_f32_16x16x32_bf16(Bt[n][k], At[m][k], acc[ai][bj][m][n], 0, 0, 0); __builtin_amdgcn_s_setprio(0); } while (0)
#define PG8_WAIT_V(n) asm volatile("s_waitcnt vmcnt(" #n ")" ::: "memory")
#define PG8_WAIT_L(n) asm volatile("s_waitcnt lgkmcnt(" #n ")" ::: "memory")
#define PG8_BAR __builtin_amdgcn_s_barrier()
#define PG8_SCHED __builtin_amdgcn_sched_barrier(0)
    Unit cur, nxt; int ui = 0;
    if (!S.next(0, cur)) return;
    f32x4 acc[2][2][4][2];
#pragma unroll
    for (int a = 0; a < 2; ++a)
#pragma unroll
        for (int b = 0; b < 2; ++b)
#pragma unroll
            for (int m = 0; m < 4; ++m)
#pragma unroll
                for (int n = 0; n < 2; ++n) acc[a][b][m][n] = (f32x4){0.f, 0.f, 0.f, 0.f};
    bf16x8 At[4][2], B0[2][2], B1[2][2];
    const char* cA = (const char*)g.A + (size_t)cur.pm * tstep; const char* cB = (const char*)g.Bt + (size_t)cur.pn * tstep;
    S.a_ready(cur);
    if constexpr (SP2) {
        PG8_STAGE(PG8_SB(0, 0), cB, voffB); PG8_STAGE(PG8_SB(0, 1), cB + hstep, voffB); PG8_STAGE(PG8_SA(0, 0), cA, voffA); PG8_STAGE(PG8_SA(0, 1), cA + hstep, voffA);
        if (wr == 1) PG8_BAR;
        PG8_WAIT_V(2); PG8_BAR;
        PG8_STAGE(PG8_SB(1, 0), cB + kstep, voffB); PG8_STAGE(PG8_SA(1, 0), cA + kstep, voffA); PG8_STAGE(PG8_SB(1, 1), cB + hstep + kstep, voffB);
        PG8_WAIT_V(6); PG8_BAR;
    } else {
        PG8_STAGE(PG8_SB(0, 0), cB, voffB); PG8_STAGE(PG8_SA(0, 0), cA, voffA); PG8_STAGE(PG8_SB(0, 1), cB + hstep, voffB); PG8_STAGE(PG8_SA(0, 1), cA + hstep, voffA);
        if (wr == 1) PG8_BAR;
        PG8_WAIT_V(4); PG8_BAR;
        PG8_STAGE(PG8_SB(1, 0), cB + kstep, voffB); PG8_STAGE(PG8_SA(1, 0), cA + kstep, voffA); PG8_STAGE(PG8_SB(1, 1), cB + hstep + kstep, voffB);
        PG8_WAIT_V(6); PG8_BAR;
    }
    for (;;) {
        const bool has_next = S.next(ui + 1, nxt);
        const char* nA = has_next ? (const char*)g.A + (size_t)nxt.pm * tstep : cA; const char* nB = has_next ? (const char*)g.Bt + (size_t)nxt.pn * tstep : cB;
        for (int t = 0; t < nt; t += 2) {
            const bool last = (t == nt - 2);
            const char* a1 = cA + (size_t)(t + 1) * kstep;
            const char* a2 = last ? nA : cA + (size_t)(t + 2) * kstep; const char* b2 = last ? nB : cB + (size_t)(t + 2) * kstep;
            const char* a3 = a2 + kstep; const char* b3 = b2 + kstep;
            if (last && has_next) S.a_ready(nxt);
            if constexpr (SP2) {
            PG8_LDB(B0, 0, 0); PG8_LDB(B1, 0, 1); PG8_SCHED; PG8_LDA(At, 0, 0); PG8_STAGE(PG8_SA(1, 1), a1 + hstep, voffA);
            PG8_WAIT_V(8); PG8_WAIT_L(0); PG8_BAR; PG8_MMA(0, 0, At, B0); PG8_MMA(0, 1, At, B1); PG8_BAR; PG8_SCHED;
            PG8_LDA(At, 0, 1); PG8_STAGE(PG8_SB(0, 0), b2, voffB); PG8_STAGE(PG8_SB(0, 1), b2 + hstep, voffB); PG8_STAGE(PG8_SA(0, 0), a2, voffA);
            PG8_WAIT_V(8); PG8_WAIT_L(0); PG8_BAR; PG8_MMA(1, 0, At, B0); PG8_MMA(1, 1, At, B1); PG8_BAR; PG8_SCHED;
            PG8_LDB(B0, 1, 0); PG8_LDB(B1, 1, 1); PG8_SCHED; PG8_LDA(At, 1, 0); PG8_STAGE(PG8_SA(0, 1), a2 + hstep, voffA);
            PG8_WAIT_V(8); PG8_WAIT_L(0); PG8_BAR; PG8_MMA(0, 0, At, B0); PG8_MMA(0, 1, At, B1); PG8_BAR; PG8_SCHED;
            PG8_LDA(At, 1, 1); PG8_STAGE(PG8_SB(1, 0), b3, voffB); PG8_STAGE(PG8_SB(1, 1), b3 + hstep, voffB); PG8_STAGE(PG8_SA(1, 0), a3, voffA);
            PG8_WAIT_V(8); PG8_WAIT_L(0); PG8_BAR; PG8_MMA(1, 0, At, B0); PG8_MMA(1, 1, At, B1); PG8_BAR; PG8_SCHED;
            } else {
            PG8_LDB(B0, 0, 0); PG8_SCHED; PG8_LDA(At, 0, 0); PG8_STAGE(PG8_SA(1, 1), a1 + hstep, voffA);
            PG8_WAIT_L(8); PG8_BAR; PG8_WAIT_L(0); PG8_MMA(0, 0, At, B0); PG8_BAR; PG8_SCHED;
            PG8_LDB(B1, 0, 1); PG8_STAGE(PG8_SB(0, 0), b2, voffB);
            PG8_BAR; PG8_WAIT_L(0); PG8_MMA(0, 1, At, B1); PG8_BAR;
            PG8_LDA(At, 0, 1); PG8_STAGE(PG8_SA(0, 0), a2, voffA);
            PG8_BAR; PG8_WAIT_L(0); PG8_MMA(1, 0, At, B0); PG8_BAR; PG8_SCHED;
            PG8_STAGE(PG8_SB(0, 1), b2 + hstep, voffB);
            PG8_WAIT_V(6); PG8_BAR; PG8_MMA(1, 1, At, B1); PG8_BAR;
            PG8_LDB(B0, 1, 0); PG8_SCHED; PG8_LDA(At, 1, 0); PG8_STAGE(PG8_SA(0, 1), a2 + hstep, voffA);
            PG8_WAIT_L(8); PG8_BAR; PG8_WAIT_L(0); PG8_MMA(0, 0, At, B0); PG8_BAR; PG8_SCHED;
            PG8_LDB(B1, 1, 1); PG8_STAGE(PG8_SB(1, 0), b3, voffB);
            PG8_BAR; PG8_WAIT_L(0); PG8_MMA(0, 1, At, B1); PG8_BAR;
            PG8_LDA(At, 1, 1); PG8_STAGE(PG8_SA(1, 0), a3, voffA);
            PG8_BAR; PG8_WAIT_L(0); PG8_MMA(1, 0, At, B0); PG8_BAR; PG8_SCHED;
            PG8_STAGE(PG8_SB(1, 1), b3 + hstep, voffB);
            PG8_WAIT_V(6); PG8_BAR; PG8_MMA(1, 1, At, B1); PG8_BAR;
            }
        }
        if constexpr (ALIGN_EPI) { if (wr == 0) PG8_BAR; }
        if constexpr (!Epi::AFTER_DRAIN) { E(acc, cur, wr, wc, fr, fq); S.done(cur); }
        if (!has_next) break;
#pragma unroll
        for (int a = 0; a < 2; ++a)
#pragma unroll
            for (int b = 0; b < 2; ++b)
#pragma unroll
                for (int m = 0; m < 4; ++m)
#pragma unroll
                    for (int n = 0; n < 2; ++n) acc[a][b][m][n] = (f32x4){0.f, 0.f, 0.f, 0.f};
        cur = nxt; cA = nA; cB = nB; ++ui;
        if constexpr (ALIGN_EPI) { if (wr == 1) PG8_BAR; }
    }
    PG8_WAIT_V(0);
    if constexpr (!ALIGN_EPI) { if (wr == 0) PG8_BAR; }
    PG8_BAR;
    if constexpr (Epi::AFTER_DRAIN) { E.fused(acc, cur, wr, wc, fr, fq, lds, wid, lane); S.done(cur); }
#undef PG8_SA
#undef PG8_SB
#undef PG8_STAGE
#undef PG8_LDA
#undef PG8_LDB
#undef PG8_MMA
#undef PG8_WAIT_V
#undef PG8_WAIT_L
#undef PG8_BAR
#undef PG8_SCHED
}
}


#ifndef PG8_SP2
#define PG8_SP2 true
#endif
#ifndef PG8_ALIGN
#define PG8_ALIGN true
#endif


namespace attn {
using bf16 = unsigned short;
using bf16x8 = __attribute__((ext_vector_type(8))) short;
using s16x4  = __attribute__((ext_vector_type(4))) short;
using f32x16 = __attribute__((ext_vector_type(16))) float;
using u32x4  = __attribute__((ext_vector_type(4))) unsigned;
constexpr int D = 128, NW = 8, QBLK = 32, KVBLK = 64;
constexpr float SCALE = 0.088388347648318440f;
constexpr float THR = 8.f;
constexpr int SHM_V = KVBLK * D * 2, SHM_K = KVBLK * D * 2;
constexpr int L_V = 0, L_K = 2 * SHM_V, L_WS = 2 * SHM_V + 2 * SHM_K, L_TB = L_WS + NW * 64 * 4, L_HIN = L_TB + 1280, ATTN_LDS = L_HIN + 8192;
constexpr long TILE_ELEMS = (long)KVBLK * 1024;
#define KSWZ(row, colB) ((row) * 256 + ((colB) ^ (((row) & 7) << 4)))
#define SBAR() __builtin_amdgcn_sched_barrier(0)
__device__ __forceinline__ int crow(int r, int hi) { return (r & 3) + 8 * (r >> 2) + 4 * hi; }
__device__ __forceinline__ unsigned cvtpk(float lo, float hi) { unsigned r; asm volatile("v_cvt_pk_bf16_f32 %0, %1, %2" : "=v"(r) : "v"(lo), "v"(hi)); return r; }
__device__ __forceinline__ float bf2f(unsigned short v) { return __uint_as_float(((unsigned)v) << 16); }

__device__ __forceinline__ void partialSM(f32x16& p0, f32x16& p1, float& m_reg, float& mn, float& alpha) {
  constexpr float C = SCALE * 1.4426950408889634f;
  float pmax = p0[0];
#pragma unroll
  for (int r = 1; r < 16; ++r) pmax = fmaxf(pmax, p0[r]);
#pragma unroll
  for (int r = 0; r < 16; ++r) pmax = fmaxf(pmax, p1[r]);
  { auto rr = __builtin_amdgcn_permlane32_swap(__float_as_uint(pmax), __float_as_uint(pmax), false, false);
    pmax = fmaxf(__uint_as_float(rr[0]), __uint_as_float(rr[1])); }
  if (__builtin_expect(__all(pmax - m_reg <= THR / SCALE), 1)) { mn = m_reg; alpha = 1.f; }
  else { mn = fmaxf(m_reg, pmax); alpha = __builtin_amdgcn_exp2f((m_reg - mn) * C); m_reg = mn; }
  float mnC = -mn * C;
#pragma unroll
  for (int r = 0; r < 16; ++r) p0[r] = fmaf(p0[r], C, mnC);
#pragma unroll
  for (int r = 0; r < 16; ++r) p1[r] = fmaf(p1[r], C, mnC);
#pragma unroll
  for (int r = 0; r < 16; ++r) p0[r] = __builtin_amdgcn_exp2f(p0[r]);
}
__device__ __forceinline__ void finishSM(f32x16& p0, f32x16& p1, float alpha, float& l_reg, bf16x8& pa0, bf16x8& pa1, bf16x8& pa2, bf16x8& pa3) {
#pragma unroll
  for (int r = 0; r < 16; ++r) p1[r] = __builtin_amdgcn_exp2f(p1[r]);
  float ps = 0;
#pragma unroll
  for (int r = 0; r < 16; ++r) ps += p0[r];
#pragma unroll
  for (int r = 0; r < 16; ++r) ps += p1[r];
  { auto rr = __builtin_amdgcn_permlane32_swap(__float_as_uint(ps), __float_as_uint(ps), false, false);
    ps = __uint_as_float(rr[0]) + __uint_as_float(rr[1]); }
  l_reg = l_reg * alpha + ps;
#define PK4(P, BASE, OUT) do { unsigned a0 = cvtpk(P[BASE + 0], P[BASE + 1]), a1 = cvtpk(P[BASE + 2], P[BASE + 3]);   \
    unsigned b0 = cvtpk(P[BASE + 4], P[BASE + 5]), b1 = cvtpk(P[BASE + 6], P[BASE + 7]);                              \
    auto r0 = __builtin_amdgcn_permlane32_swap(a0, b0, false, false); auto r1 = __builtin_amdgcn_permlane32_swap(a1, b1, false, false); \
    u32x4 w = {r0[0], r1[0], r0[1], r1[1]}; OUT = *reinterpret_cast<bf16x8*>(&w); } while (0)
  PK4(p0, 0, pa0); PK4(p0, 8, pa1); PK4(p1, 0, pa2); PK4(p1, 8, pa3);
#undef PK4
}
__device__ __forceinline__ void bias_init(f32x16& p0, f32x16& p1, int d, int qin, int hi, const float* tb) {
  if (d < 0 || d > 8) {
#pragma unroll
    for (int r = 0; r < 16; ++r) { p0[r] = -INFINITY; p1[r] = -INFINITY; } }
  else if (d >= 3) { const float c = tb[256];
#pragma unroll
    for (int r = 0; r < 16; ++r) { p0[r] = c; p1[r] = c; } }
  else { const float* tp = tb + (64 * d + qin + 128 - 4 * hi - 95);
#pragma unroll
    for (int r = 0; r < 16; ++r) { const int kv = (r & 3) + 8 * (r >> 2); p0[r] = tp[95 - kv]; p1[r] = tp[95 - kv - 32]; } }
}
__device__ __forceinline__ void qkt(f32x16& p0, f32x16& p1, const char* Ks, const bf16x8* qr, int r32, int hi) {
#pragma unroll
  for (int d0 = 0; d0 < 8; ++d0) { int cb = (d0 * 16 + hi * 8) * 2;
    bf16x8 b0 = *reinterpret_cast<const bf16x8*>(Ks + KSWZ(r32, cb));
    bf16x8 b1 = *reinterpret_cast<const bf16x8*>(Ks + KSWZ(32 + r32, cb));
    p0 = __builtin_amdgcn_mfma_f32_32x32x16_bf16(b0, qr[d0], p0, 0, 0, 0);
    p1 = __builtin_amdgcn_mfma_f32_32x32x16_bf16(b1, qr[d0], p1, 0, 0, 0); }
}
__device__ __forceinline__ int v_st(int k, int c) { const int kk = (k & ~0xC) | ((k & 4) << 1) | ((k & 8) >> 1); return ((kk >> 3) * 4 + (c >> 5)) * 512 + ((kk & 7) * 32 + (c & 31)) * 2; }
__device__ __forceinline__ int v_rd_base(int lane) { return ((lane & 3) << 3) | (((lane >> 2) & 3) << 6) | (((lane >> 4) & 1) << 5) | (((lane >> 5) & 1) << 8); }
constexpr int v_rd_off(int d0, int ks, int half) { return d0 * 512 + ks * 4096 + half * 2048; }
template <int OFF> __device__ __forceinline__ s16x4 tr_read(int vb) {
  s16x4 r; asm volatile("ds_read_b64_tr_b16 %0, %1 offset:%2" : "=&v"(r) : "v"(vb), "i"(OFF) : "memory"); return r;
}
template <int D0> __device__ __forceinline__ void pv_one(f32x16& od, int vb, bf16x8 pa0, bf16x8 pa1, bf16x8 pa2, bf16x8 pa3) {
  const s16x4 l0 = tr_read<v_rd_off(D0, 0, 0)>(vb), h0 = tr_read<v_rd_off(D0, 0, 1)>(vb), l1 = tr_read<v_rd_off(D0, 1, 0)>(vb), h1 = tr_read<v_rd_off(D0, 1, 1)>(vb);
  const s16x4 l2 = tr_read<v_rd_off(D0, 2, 0)>(vb), h2 = tr_read<v_rd_off(D0, 2, 1)>(vb), l3 = tr_read<v_rd_off(D0, 3, 0)>(vb), h3 = tr_read<v_rd_off(D0, 3, 1)>(vb);
  asm volatile("s_waitcnt lgkmcnt(0)" ::: "memory"); SBAR();
#define PK(L, H) (bf16x8){L[0], L[1], L[2], L[3], H[0], H[1], H[2], H[3]}
  od = __builtin_amdgcn_mfma_f32_32x32x16_bf16(pa0, PK(l0, h0), od, 0, 0, 0);
  od = __builtin_amdgcn_mfma_f32_32x32x16_bf16(pa1, PK(l1, h1), od, 0, 0, 0);
  od = __builtin_amdgcn_mfma_f32_32x32x16_bf16(pa2, PK(l2, h2), od, 0, 0, 0);
  od = __builtin_amdgcn_mfma_f32_32x32x16_bf16(pa3, PK(l3, h3), od, 0, 0, 0);
#undef PK
}
__device__ __forceinline__ void pv_d0(f32x16* o, int vb, bf16x8 pa0, bf16x8 pa1, bf16x8 pa2, bf16x8 pa3) {
  pv_one<0>(o[0], vb, pa0, pa1, pa2, pa3); pv_one<1>(o[1], vb, pa0, pa1, pa2, pa3); pv_one<2>(o[2], vb, pa0, pa1, pa2, pa3); pv_one<3>(o[3], vb, pa0, pa1, pa2, pa3);
}

struct AUnit {
  const bf16* wsb;
  const bf16* q;
  long kA, vA;
  long kB, vB;
  int tsw, t0, nt, nwq;
};
__device__ __forceinline__ void attn_unit(const AUnit& u, char* lds, f32x16 (&o)[4], float (&rli)[16]) {
  const int tid = threadIdx.x, wid = __builtin_amdgcn_readfirstlane(tid >> 6), lane = tid & 63, r32 = lane & 31, hi = lane >> 5;
  char* V_lds = lds + L_V; char* K_lds = lds + L_K;
  float* wsf = (float*)(lds + L_WS) + wid * 64; float* li_l = wsf; float* al_l = wsf + 32;
  const float* tb = (const float*)(lds + L_TB);
  float m_reg = -1e30f, l_reg = 0; bf16x8 qr[8];
#pragma unroll
  for (int d = 0; d < 4; ++d) o[d] = f32x16{};
  const bool wq = wid < u.nwq;
  const int wrow = wq ? wid * QBLK : (wid & 1) * QBLK;
  const bf16* Qw = u.q + (long)(wrow + r32) * 1024 + hi * 8;
#pragma unroll
  for (int d0 = 0; d0 < 8; ++d0) qr[d0] = *reinterpret_cast<const bf16x8*>(Qw + d0 * 16);
  const int sr = tid >> 4, sc = (tid & 15) * 8, vst0 = v_st(sr, sc), vst1 = v_st(32 + sr, sc);
  const int vb0 = (int)(uintptr_t)V_lds + v_rd_base(lane);
  const int qin = (wid & 1) * QBLK + r32, wch = wid >> 1;
  struct { bf16x8 vs0, vs1, ks0, ks1; } sr_[2];
#define TOFF(t, A, B) (((t) < u.tsw) ? (A) + (long)(t) * TILE_ELEMS : (B))
#define SLOAD(i, t) do { const bf16* kp_ = u.wsb + TOFF(t, u.kA, u.kB) + (long)sr * 1024 + sc; const bf16* vp_ = u.wsb + TOFF(t, u.vA, u.vB) + (long)sr * 1024 + sc; \
    sr_[i].vs0 = *reinterpret_cast<const bf16x8*>(vp_); sr_[i].vs1 = *reinterpret_cast<const bf16x8*>(vp_ + 32 * 1024); \
    sr_[i].ks0 = *reinterpret_cast<const bf16x8*>(kp_); sr_[i].ks1 = *reinterpret_cast<const bf16x8*>(kp_ + 32 * 1024); } while (0)
#define SWRITE(b, i) do { *(bf16x8*)(V_lds + (b) * SHM_V + vst0) = sr_[i].vs0; *(bf16x8*)(V_lds + (b) * SHM_V + vst1) = sr_[i].vs1; int kc = sc * 2; \
    *(bf16x8*)(K_lds + (b) * SHM_K + KSWZ(sr, kc)) = sr_[i].ks0; *(bf16x8*)(K_lds + (b) * SHM_K + KSWZ(32 + sr, kc)) = sr_[i].ks1; } while (0)
#define SWAIT() asm volatile("s_waitcnt vmcnt(4)" ::: "memory")
#define RESC(a) do { if (__any((a) < 1.f)) { if (hi == 0) al_l[r32] = (a); asm volatile("s_waitcnt lgkmcnt(0)" ::: "memory"); \
    _Pragma("unroll") for (int d = 0; d < 4; ++d) _Pragma("unroll") for (int r = 0; r < 16; ++r) o[d][r] *= al_l[crow(r, hi)]; } } while (0)
#define DIST(t) (wq ? (wch + 8 - (t)) : -1)
  f32x16 pA0, pA1, pB0, pB1; float mnA, mnB, alA, alB; bf16x8 pa0, pa1, pa2, pa3; const int NT = u.nt, T0 = u.t0;
  constexpr int SE = 0, SO = 1;
  SLOAD(SE, T0); asm volatile("s_waitcnt vmcnt(0)" ::: "memory"); SWRITE(0, SE); __syncthreads();
  bias_init(pA0, pA1, DIST(T0), qin, hi, tb); qkt(pA0, pA1, K_lds, qr, r32, hi); partialSM(pA0, pA1, m_reg, mnA, alA);
  SLOAD(SO, T0 + 1); SLOAD(SE, T0 + 2);
  SWAIT(); SWRITE(1, SO); __syncthreads();
  for (int j = T0 + 1; j + 1 < NT; j += 2) {
    SBAR(); bias_init(pB0, pB1, DIST(j), qin, hi, tb); qkt(pB0, pB1, K_lds + SHM_K, qr, r32, hi);
    finishSM(pA0, pA1, alA, l_reg, pa0, pa1, pa2, pa3); SBAR();
    SLOAD(SO, j + 2); SBAR();
    pv_d0(o, vb0, pa0, pa1, pa2, pa3); partialSM(pB0, pB1, m_reg, mnB, alB);
    __syncthreads(); SWAIT(); SWRITE(0, SE);
    RESC(alB); __syncthreads();
    SBAR(); bias_init(pA0, pA1, DIST(j + 1), qin, hi, tb); qkt(pA0, pA1, K_lds, qr, r32, hi);
    finishSM(pB0, pB1, alB, l_reg, pa0, pa1, pa2, pa3); SBAR();
    if (j + 3 < NT) SLOAD(SE, j + 3); SBAR();
    pv_d0(o, vb0 + SHM_V, pa0, pa1, pa2, pa3); partialSM(pA0, pA1, m_reg, mnA, alA);
    __syncthreads(); SWAIT(); SWRITE(1, SO);
    RESC(alA); __syncthreads();
  }
  SBAR(); bias_init(pB0, pB1, DIST(NT - 1), qin, hi, tb); qkt(pB0, pB1, K_lds + SHM_K, qr, r32, hi);
  finishSM(pA0, pA1, alA, l_reg, pa0, pa1, pa2, pa3); SBAR();
  pv_d0(o, vb0, pa0, pa1, pa2, pa3); partialSM(pB0, pB1, m_reg, mnB, alB);
  RESC(alB);
  finishSM(pB0, pB1, alB, l_reg, pa0, pa1, pa2, pa3); SBAR();
  pv_d0(o, vb0 + SHM_V, pa0, pa1, pa2, pa3);
#undef DIST
  if (hi == 0) li_l[r32] = l_reg; asm volatile("s_waitcnt lgkmcnt(0)" ::: "memory");
#pragma unroll
  for (int r = 0; r < 16; ++r) rli[r] = __builtin_amdgcn_rcpf(li_l[crow(r, hi)]);
  __syncthreads();
#undef TOFF
#undef SLOAD
#undef SWRITE
#undef SWAIT
#undef RESC
}
#undef SBAR
}

#define GAS __attribute__((address_space(1)))
#define LAS __attribute__((address_space(3)))
typedef unsigned short bf16;
typedef unsigned v4u __attribute__((ext_vector_type(4)));
typedef float f32x4 __attribute__((ext_vector_type(4)));
typedef short bf16x8 __attribute__((ext_vector_type(8)));
typedef GAS unsigned gu32;
typedef GAS unsigned long long gu64;
#define RLX_AGENT __ATOMIC_RELAXED, __HIP_MEMORY_SCOPE_AGENT
#define LDS_WAIT() asm volatile("s_waitcnt lgkmcnt(0)" ::: "memory")
#define VM_WAIT() asm volatile("s_waitcnt vmcnt(0)" ::: "memory")
__device__ __forceinline__ unsigned long long rt() { return __builtin_amdgcn_s_memrealtime(); }
__device__ __forceinline__ unsigned f2bf(float f) { unsigned u = __builtin_bit_cast(unsigned, f); return (u + 0x7fffu + ((u >> 16) & 1u)) >> 16; }
__device__ __forceinline__ unsigned pk2(float lo, float hi) { return f2bf(lo) | (f2bf(hi) << 16); }

#define XB_TMO      128
#define XB_XCNT(j)  (256  + 64 * (j))
#define XB_XSUB(j)  (1280 + 64 * (j))
#define XB_XGEN(j)  (2304 + 64 * (j))
#define XB_TOP      3328
#define XB_TOPGEN   3392
#define XCD_BAR_WORDS 3456
#define XB_SPIN_CAP (1u << 18)

__device__ __forceinline__ unsigned xb_ld(unsigned* p)              { return __hip_atomic_load(p, __ATOMIC_RELAXED, __HIP_MEMORY_SCOPE_AGENT); }
__device__ __forceinline__ unsigned xb_add(unsigned* p, unsigned v) { return __hip_atomic_fetch_add(p, v, __ATOMIC_RELAXED, __HIP_MEMORY_SCOPE_AGENT); }
__device__ __forceinline__ unsigned xb_xcc_id() { return (unsigned)__builtin_amdgcn_s_getreg((3 << 11) | 20) & 0xFu; }
#define XB_SPIN(cond, bar) do { unsigned _sp = 0; while (cond) { __builtin_amdgcn_s_sleep(1); \
    if ((++_sp & 255u) == 0u) { if (xb_ld(&(bar)[XB_TMO])) break; if (_sp > XB_SPIN_CAP) { atomicAdd(&(bar)[XB_TMO], 1u); break; } } } } while (0)

struct XcdBarrier {
    unsigned* bar; unsigned x;
    volatile LAS unsigned* st;
};

__device__ __forceinline__ XcdBarrier xcd_barrier_post(unsigned* bar, volatile LAS unsigned* st) {
    XcdBarrier b; b.bar = bar; b.x = xb_xcc_id(); b.st = st;
    if (threadIdx.x == 0) (void)xb_add(&bar[XB_XCNT(b.x)], 1u);
    return b;
}
__device__ __forceinline__ void xcd_barrier_complete(unsigned* bar, unsigned x, unsigned& nloc, unsigned& nx) {
    const unsigned G = gridDim.x * gridDim.y * gridDim.z;
    unsigned sum, cnt, mine, sp = 0u;
    for (;;) {
        sum = 0u; cnt = 0u; mine = 0u;
#pragma unroll
        for (unsigned j = 0; j < 16; ++j) { const unsigned c = xb_ld(&bar[XB_XCNT(j)]); sum += c; cnt += (c > 0u) ? 1u : 0u; mine = (j == x) ? c : mine; }
        if (sum == G) break;
        __builtin_amdgcn_s_sleep(1);
        if ((++sp & 255u) == 0u) { if (xb_ld(&bar[XB_TMO])) break; if (sp > XB_SPIN_CAP) { atomicAdd(&bar[XB_TMO], 1u); break; } }
    }
    nloc = mine > 0u ? mine : 1u; nx = cnt > 0u ? cnt : 1u;
}

__device__ __forceinline__ void xcd_barrier(const XcdBarrier& b) {
    asm volatile("s_waitcnt vmcnt(0)" ::: "memory");
    __syncthreads();
    if (threadIdx.x == 0) {
        unsigned* bar = b.bar;
        __builtin_amdgcn_s_waitcnt(0);
        unsigned nloc = b.st[0], nx = b.st[1];
        if (nloc == 0u) { xcd_barrier_complete(bar, b.x, nloc, nx); b.st[0] = nloc; b.st[1] = nx; }
        const unsigned old = xb_add(&bar[XB_XSUB(b.x)], 1u);
        const unsigned gen = old / nloc;
        if (old + 1u == (gen + 1u) * nloc) {
            __builtin_amdgcn_fence(__ATOMIC_RELEASE, "agent");
            asm volatile("s_waitcnt vmcnt(0)" ::: "memory");
            const unsigned og = xb_add(&bar[XB_TOP], 1u);
            const unsigned tg = og / nx;
            if (og + 1u == (tg + 1u) * nx) xb_add(&bar[XB_TOPGEN], 1u);
            else XB_SPIN(xb_ld(&bar[XB_TOPGEN]) == tg, bar);
            __builtin_amdgcn_fence(__ATOMIC_ACQUIRE, "agent");
            xb_add(&bar[XB_XGEN(b.x)], 1u);
            asm volatile("s_waitcnt vmcnt(0)" ::: "memory");
        } else {
            XB_SPIN(xb_ld(&bar[XB_XGEN(b.x)]) == gen, bar);
            __builtin_amdgcn_fence(__ATOMIC_ACQUIRE, "agent");
            asm volatile("s_waitcnt vmcnt(0)" ::: "memory");
        }
    }
    __syncthreads();
}


constexpr int NWAVES = 8;
#ifndef MK_N_LAUNCHES
#define MK_N_LAUNCHES 1
#endif
constexpr int N_PHASES = 10;
constexpr int N_LAUNCHES = MK_N_LAUNCHES;
static_assert(N_LAUNCHES == 1 || N_LAUNCHES == N_PHASES, "MK_N_LAUNCHES is 1 or 10");
#ifndef MK_REPEAT_PHASE
#define MK_REPEAT_PHASE (-1)
#endif

constexpr int DM = 1024, BP = 8, TP = 8192, BS = 8, TSQ = 64, MP = BP * TP, MS = BS * TSQ, M = MP + MS;
constexpr int DIN = 7168, FF = 4096, NH = 8, HD = 128, CROWS = 512, NCHUNK = TP / 64;
constexpr float LN_EPS = 1e-5f, ALPHA = 1.189207115002721f;
static_assert(M % 256 == 0, "row tiles");
enum { ZXR = 0, ZGL = 1, ZQ = 2, ZK = 3, ZV = 4, ZGA = 5, ZGB = 6 };
constexpr int MOD_SH1 = 0, MOD_SC1 = 1024, MOD_G1 = 2048, MOD_SH2 = 3072, MOD_SC2 = 4096, MOD_G2 = 5120;

constexpr size_t MiB = 1u << 20;
constexpr size_t WS_CTL = 0, CTL_ZERO_BYTES = 1 * MiB;
constexpr size_t WS_MOD = 1 * MiB;
constexpr size_t WS_WIN = 2 * MiB, WS_WOUT = 16 * MiB, WS_WUP = 18 * MiB, WS_WDN = 26 * MiB, WS_WRG = 34 * MiB, WS_WIG = 34 * MiB + 256 * 1024;
constexpr size_t WS_CK = 35 * MiB, WS_CV = 43 * MiB;
constexpr size_t WS_AGG = 51 * MiB;
constexpr size_t WS_Z = 64 * MiB, ZBUF = (size_t)M * 1024 * 2;
constexpr size_t WS_END = WS_Z + 7 * ZBUF;
constexpr size_t WS_MERGED = WS_Z, WS_U2 = WS_Z, WS_X1 = WS_Z + ZBUF, WS_H = WS_Z + 3 * ZBUF;
constexpr size_t OUT_YP = 0, OUT_YS = 67108864, OUT_KP = 67633152, OUT_VP = 71827456, OUT_CP = 76021760, OUT_HP = 76046336, OUT_KS = 76054528, OUT_VS = 76578816, OUT_CS = 77103104, OUT_HS = 77127680, OUT_TOTAL = 77135872;
constexpr int CW_TMO = 0, CW_CODE = 1, CW_BAR = 4096;

constexpr int RING_OFF = 0, RING_BYTES = 131072;
constexpr int SCRATCH_BYTES = 155648;
constexpr int LDSCTL_OFF = SCRATCH_BYTES, MISC_OFF = LDSCTL_OFF + 320;
constexpr int LDS_BYTES = 163840;
static_assert(MISC_OFF + 128 <= LDS_BYTES, "LDS map");
constexpr int LW_RG = 0, LW_IG = 32768, L_XC = 65536, L_A = 81920, L_B = 114688, L_AGG = 147456;
static_assert(L_AGG + 4096 <= SCRATCH_BYTES && attn::ATTN_LDS <= SCRATCH_BYTES, "LDS scratch");


struct Frame {
    LAS unsigned char* lds;
    volatile LAS unsigned* MISC;
    gu32* ctl;
    int tid, lane, wave;
    int vcu, G;
    const float *x_p, *x_s, *c_p, *c_s, *cache_k, *cache_v, *state_conv, *state_lru, *w_ada, *b_ada, *w_in, *conv_w, *conv_b, *w_rg, *b_rg, *w_ig, *b_ig, *lam, *rel_bias,
                *w_out, *ln1_g, *ln1_b, *w_up, *b_up, *w_down, *b_down, *ln2_g, *ln2_b;
    float* out; unsigned char* ws;
    float* mod; float* agg;
    bf16 *Win_t, *Wout_t, *Wup_t, *Wdn_t, *Wrg_t, *Wig_t, *CK, *CV, *Z;
};
__device__ __forceinline__ bf16* zbuf(Frame& F, int i) { return (bf16*)(F.ws + WS_Z + (size_t)i * ZBUF); }
__device__ __forceinline__ float sigmoid_f(float x) { return __builtin_amdgcn_rcpf(1.f + __builtin_amdgcn_exp2f(-1.4426950408889634f * x)); }
__device__ __forceinline__ float gelu_tanh_f(float x) { const float y = 0.7978845608028654f * (x + 0.044715f * x * x * x); return x * sigmoid_f(2.f * y); }
__device__ __forceinline__ float bf2f(unsigned short v) { return __uint_as_float(((unsigned)v) << 16); }
__device__ __forceinline__ int batch_of_row(int row) { return row < MP ? (row >> 13) : 8 + ((row - MP) >> 6); }

__device__ __forceinline__ float wave_sum(float v) {
#pragma unroll
    for (int o = 1; o < 64; o <<= 1) v += __shfl_xor(v, o);
    return v;
}
__device__ __forceinline__ void p0_transpose_item(const float* W, int K, int N, bf16* WT, int row_off, LAS float* scr, int item, int lane) {
    const int nblk = N / 32, kb = item / nblk, nb = item % nblk, k0 = 64 * kb, n0 = 32 * nb;
#pragma unroll 8
    for (int i = 0; i < 32; ++i) { const int kk = 2 * i + (lane >> 5); scr[kk * 33 + (lane & 31)] = W[(size_t)(k0 + kk) * N + n0 + (lane & 31)]; }
    LDS_WAIT(); asm volatile("" ::: "memory");
    const int c = lane & 7;
#pragma unroll
    for (int j = 0; j < 4; ++j) { const int n = (lane >> 3) + 8 * j; const LAS float* s = scr + (8 * c) * 33 + n;
        v4u o; o.x = pk2(s[0 * 33], s[1 * 33]); o.y = pk2(s[2 * 33], s[3 * 33]); o.z = pk2(s[4 * 33], s[5 * 33]); o.w = pk2(s[6 * 33], s[7 * 33]);
        *(GAS v4u*)(WT + (size_t)(row_off + n0 + n) * K + k0 + 8 * c) = o; }
    LDS_WAIT(); asm volatile("" ::: "memory");
}
__device__ __forceinline__ void p0_mod_item(Frame& F, const LAS float* sl, int it) {
    const int cb = it >> 2, bq = it & 3, kq = F.lane >> 4, cq = F.lane & 15, col = 64 * cb + 4 * cq;
    f32x4 acc[4];
#pragma unroll
    for (int bb = 0; bb < 4; ++bb) acc[bb] = (f32x4){0.f, 0.f, 0.f, 0.f};
    const float* wp = F.w_ada + (size_t)(256 * kq) * 6144 + col;
    const LAS float* sp = sl + (4 * bq) * 1024 + 256 * kq;
#pragma unroll 2
    for (int kk = 0; kk < 256; kk += 4) {
        f32x4 s[4];
#pragma unroll
        for (int bb = 0; bb < 4; ++bb) s[bb] = *(const LAS f32x4*)(sp + bb * 1024 + kk);
#pragma unroll
        for (int i = 0; i < 4; ++i) { const f32x4 w = *(const f32x4*)(wp + (size_t)(kk + i) * 6144);
#pragma unroll
            for (int bb = 0; bb < 4; ++bb) acc[bb] += w * s[bb][i]; }
    }
#pragma unroll
    for (int bb = 0; bb < 4; ++bb)
#pragma unroll
        for (int e = 0; e < 4; ++e) { float v = acc[bb][e]; v += __shfl_xor(v, 16); v += __shfl_xor(v, 32); acc[bb][e] = v; }
    if (kq == 0) { const f32x4 bv = *(const f32x4*)(F.b_ada + col);
#pragma unroll
        for (int bb = 0; bb < 4; ++bb) *(f32x4*)(F.mod + (size_t)(4 * bq + bb) * 6144 + col) = acc[bb] + bv; }
}
__device__ __forceinline__ void p0_prologue(Frame& F) {
    LAS float* sl = (LAS float*)F.lds;
    for (int i = F.tid; i < 16 * 1024; i += NWAVES * 64) { const float c = i < 8192 ? F.c_p[i] : F.c_s[i - 8192]; sl[i] = c / (1.f + __expf(-c)); }
    __syncthreads();
    LAS float* scr = (LAS float*)(F.lds + 65536 + F.wave * 8448);
    const int gw = F.vcu * NWAVES + F.wave, NGW = F.G * NWAVES;
    constexpr int I_MOD = 384, I_IN = (DM / 64) * (DIN / 32), I_OUT = (DM / 64) * (DM / 32), I_UP = (DM / 64) * (FF / 32), I_DN = (FF / 64) * (DM / 32), I_G = 8 * 8;
    constexpr int NITEMS = I_MOD + I_IN + I_OUT + I_UP + I_DN + 2 * I_G;
    for (int it = gw; it < NITEMS; it += NGW) {
        int r = it;
        if (r < I_MOD) { p0_mod_item(F, sl, r); continue; } r -= I_MOD;
        if (r < I_IN) { p0_transpose_item(F.w_in, DM, DIN, F.Win_t, 0, scr, r, F.lane); continue; } r -= I_IN;
        if (r < I_OUT) { p0_transpose_item(F.w_out, DM, DM, F.Wout_t, 0, scr, r, F.lane); continue; } r -= I_OUT;
        if (r < I_UP) { p0_transpose_item(F.w_up, DM, FF, F.Wup_t, 0, scr, r, F.lane); continue; } r -= I_UP;
        if (r < I_DN) { p0_transpose_item(F.w_down, FF, DM, F.Wdn_t, 0, scr, r, F.lane); continue; } r -= I_DN;
        if (r < I_G) { const int n = r >> 3; p0_transpose_item(F.w_rg + (size_t)n * 16384, 128, 128, F.Wrg_t + (size_t)n * 16384, 0, scr, r & 7, F.lane); continue; } r -= I_G;
        { const int n = r >> 3; p0_transpose_item(F.w_ig + (size_t)n * 16384, 128, 128, F.Wig_t + (size_t)n * 16384, 0, scr, r & 7, F.lane); }
    }
    constexpr int NC8 = 4194304 / 8;
    for (int i = gw * 64 + F.lane; i < 2 * NC8; i += NGW * 64) {
        const bool isk = i < NC8; const int j = isk ? i : i - NC8;
        const float* src = (isk ? F.cache_k : F.cache_v) + (size_t)j * 8;
        const f32x4 a = *(const f32x4*)src, b = *(const f32x4*)(src + 4);
        v4u o; o.x = pk2(a.x, a.y); o.y = pk2(a.z, a.w); o.z = pk2(b.x, b.y); o.w = pk2(b.z, b.w);
        *(GAS v4u*)((isk ? F.CK : F.CV) + (size_t)j * 8) = o;
    }
}
__device__ __forceinline__ void p1_upass(Frame& F, bf16* U) {
    const int gw = F.vcu * NWAVES + F.wave, NGW = F.G * NWAVES;
    for (int m = gw; m < M; m += NGW) {
        const float* xr = m < MP ? F.x_p + (size_t)m * 1024 : F.x_s + (size_t)(m - MP) * 1024;
        const float* md = F.mod + (size_t)batch_of_row(m) * 6144;
        GAS unsigned long long* o8 = (GAS unsigned long long*)(U + (size_t)m * 1024) + F.lane;
#pragma unroll
        for (int j = 0; j < 4; ++j) { const int idx = 4 * F.lane + 256 * j;
            const f32x4 x = *(const f32x4*)(xr + idx), sh = *(const f32x4*)(md + MOD_SH1 + idx), sc = *(const f32x4*)(md + MOD_SC1 + idx);
            const f32x4 u = x * (sc + 1.0f) + sh;
            o8[64 * j] = (unsigned long long)pk2(u.x, u.y) | ((unsigned long long)pk2(u.z, u.w) << 32); }
    }
}
template <bool FIRST> __device__ __forceinline__ void ln_pass(Frame& F, const float* R, float* X1, bf16* U2, const float* g, const float* bta) {
    const int gw = F.vcu * NWAVES + F.wave, NGW = F.G * NWAVES;
    for (int m = gw; m < M; m += NGW) {
        const float* rr = R + (size_t)m * 1024;
        f32x4 v[4]; float s = 0.f;
#pragma unroll
        for (int j = 0; j < 4; ++j) { v[j] = *(const f32x4*)(rr + 4 * F.lane + 256 * j); s += (v[j].x + v[j].y) + (v[j].z + v[j].w); }
        const float mean = wave_sum(s) * (1.f / 1024.f); float s2 = 0.f;
#pragma unroll
        for (int j = 0; j < 4; ++j) { v[j] = v[j] - mean; s2 += (v[j].x * v[j].x + v[j].y * v[j].y) + (v[j].z * v[j].z + v[j].w * v[j].w); }
        const float rstd = 1.f / sqrtf(wave_sum(s2) * (1.f / 1024.f) + LN_EPS);
        const float* md = F.mod + (size_t)batch_of_row(m) * 6144;
#pragma unroll
        for (int j = 0; j < 4; ++j) { const int idx = 4 * F.lane + 256 * j;
            const f32x4 y = v[j] * rstd * *(const f32x4*)(g + idx) + *(const f32x4*)(bta + idx);
            *(f32x4*)(X1 + (size_t)m * 1024 + idx) = y;
            if (FIRST) { const f32x4 sh = *(const f32x4*)(md + MOD_SH2 + idx), sc = *(const f32x4*)(md + MOD_SC2 + idx); const f32x4 u = y * (sc + 1.0f) + sh;
                *((GAS unsigned long long*)(U2 + (size_t)m * 1024 + idx)) = (unsigned long long)pk2(u.x, u.y) | ((unsigned long long)pk2(u.z, u.w) << 32); } }
    }
}
#define LSWZ(row, colB) ((row) * 256 + ((colB) ^ (((row) & 7) << 4)))
__device__ __forceinline__ void p3_lru(Frame& F, bf16* Y0, bf16* Y1) {
    LAS unsigned char* L = F.lds;
    const int n = F.vcu & 7, kidx = F.vcu >> 3, nck = F.G >> 3;
    const bf16* XR = zbuf(F, ZXR); const bf16* GL = zbuf(F, ZGL); const bf16* GA = zbuf(F, ZGA);
    for (int idx = F.tid; idx < 2 * 2048; idx += NWAVES * 64) { const int g = idx >> 11, r = (idx >> 4) & 127, ch = idx & 15;
        const bf16* src = (g ? F.Wig_t : F.Wrg_t) + ((size_t)(n * 128 + r)) * 128 + ch * 8;
        *(LAS v4u*)(L + (g ? LW_IG : LW_RG) + LSWZ(r, ch * 16)) = *(const v4u*)src; }
    const int w = F.wave, rb = w & 3, chf = w >> 2, fr = F.lane & 15, fq = F.lane >> 4;
    float brg[4], big[4], c8[4];
#pragma unroll
    for (int cb = 0; cb < 4; ++cb) { const int dch = n * 128 + 64 * chf + 16 * cb + fr; brg[cb] = F.b_rg[dch]; big[cb] = F.b_ig[dch]; c8[cb] = -8.0f * log1pf(__expf(-F.lam[dch])) * 1.4426950408889634f; }
    const int nitems = 1024 + 8;
    for (int q = kidx; q < nitems; q += nck) {
        const bool smp = q >= 1024; const int b = smp ? q - 1024 : q >> 7, j = smp ? 0 : q & 127;
        const size_t row0 = smp ? (size_t)MP + b * 64 : (size_t)b * TP + j * 64;
        __syncthreads();
        { const int t = F.tid >> 3, cg = F.tid & 7;
#pragma unroll
          for (int half = 0; half < 2; ++half) { const int cl = cg * 16 + 8 * half, ch = n * 128 + cl;
            float x[4][8];
#pragma unroll
            for (int k = 0; k < 4; ++k) { const int tt = t - 3 + k;
                if (tt >= 0 || (!smp && j > 0)) { const v4u raw = *(const v4u*)(XR + (row0 + tt) * 1024 + ch);
                    x[k][0] = __uint_as_float(raw.x << 16); x[k][1] = __uint_as_float(raw.x & 0xffff0000u); x[k][2] = __uint_as_float(raw.y << 16); x[k][3] = __uint_as_float(raw.y & 0xffff0000u);
                    x[k][4] = __uint_as_float(raw.z << 16); x[k][5] = __uint_as_float(raw.z & 0xffff0000u); x[k][6] = __uint_as_float(raw.w << 16); x[k][7] = __uint_as_float(raw.w & 0xffff0000u); }
                else if (smp) { const float* sp = F.state_conv + ((size_t)b * 3 + (3 + tt)) * 1024 + ch; const f32x4 a = *(const f32x4*)sp, c = *(const f32x4*)(sp + 4);
                    x[k][0] = a.x; x[k][1] = a.y; x[k][2] = a.z; x[k][3] = a.w; x[k][4] = c.x; x[k][5] = c.y; x[k][6] = c.z; x[k][7] = c.w; }
                else {
#pragma unroll
                    for (int e = 0; e < 8; ++e) x[k][e] = 0.f; } }
            float xc[8];
            { const f32x4 c0 = *(const f32x4*)(F.conv_b + ch), c1 = *(const f32x4*)(F.conv_b + ch + 4); xc[0] = c0.x; xc[1] = c0.y; xc[2] = c0.z; xc[3] = c0.w; xc[4] = c1.x; xc[5] = c1.y; xc[6] = c1.z; xc[7] = c1.w; }
#pragma unroll
            for (int k = 0; k < 4; ++k) { const f32x4 w0 = *(const f32x4*)(F.conv_w + (size_t)k * 1024 + ch), w1 = *(const f32x4*)(F.conv_w + (size_t)k * 1024 + ch + 4);
                xc[0] = fmaf(x[k][0], w0.x, xc[0]); xc[1] = fmaf(x[k][1], w0.y, xc[1]); xc[2] = fmaf(x[k][2], w0.z, xc[2]); xc[3] = fmaf(x[k][3], w0.w, xc[3]);
                xc[4] = fmaf(x[k][4], w1.x, xc[4]); xc[5] = fmaf(x[k][5], w1.y, xc[5]); xc[6] = fmaf(x[k][6], w1.z, xc[6]); xc[7] = fmaf(x[k][7], w1.w, xc[7]); }
            v4u o; o.x = pk2(xc[0], xc[1]); o.y = pk2(xc[2], xc[3]); o.z = pk2(xc[4], xc[5]); o.w = pk2(xc[6], xc[7]);
            *(LAS v4u*)(L + L_XC + LSWZ(t, cl * 2)) = o;
            if (t >= 61 && (smp || j == NCHUNK - 1)) {
                float* oc = F.out + (smp ? OUT_CS : OUT_CP) + ((size_t)b * 3 + (t - 61)) * 1024 + ch;
                *(f32x4*)oc = (f32x4){x[3][0], x[3][1], x[3][2], x[3][3]}; *(f32x4*)(oc + 4) = (f32x4){x[3][4], x[3][5], x[3][6], x[3][7]}; }
          } }
        __syncthreads();
        { f32x4 acc[2][4];
#pragma unroll
          for (int g = 0; g < 2; ++g)
#pragma unroll
            for (int cb = 0; cb < 4; ++cb) acc[g][cb] = (f32x4){0.f, 0.f, 0.f, 0.f};
#pragma unroll
          for (int ks = 0; ks < 4; ++ks) { const int kb = (32 * ks + 8 * fq) * 2;
            const bf16x8 A = *(const LAS bf16x8*)(L + L_XC + LSWZ(16 * rb + fr, kb));
#pragma unroll
            for (int cb = 0; cb < 4; ++cb) { const int d = 64 * chf + 16 * cb + fr;
                const bf16x8 Br = *(const LAS bf16x8*)(L + LW_RG + LSWZ(d, kb)), Bi = *(const LAS bf16x8*)(L + LW_IG + LSWZ(d, kb));
                acc[0][cb] = __builtin_amdgcn_mfma_f32_16x16x32_bf16(A, Br, acc[0][cb], 0, 0, 0);
                acc[1][cb] = __builtin_amdgcn_mfma_f32_16x16x32_bf16(A, Bi, acc[1][cb], 0, 0, 0); } }
          const bool reset = (!smp && j == 0 && rb == 0 && fq == 0);
#pragma unroll
          for (int cb = 0; cb < 4; ++cb)
#pragma unroll
            for (int rg = 0; rg < 4; ++rg) { const int t = 16 * rb + 4 * fq + rg, dl = 64 * chf + 16 * cb + fr;
                const float r = sigmoid_f(acc[0][cb][rg] + brg[cb]), ig = sigmoid_f(acc[1][cb][rg] + big[cb]);
                float a = __builtin_amdgcn_exp2f(c8[cb] * r); float mult = __builtin_amdgcn_sqrtf(fmaxf(1.f - a * a, 0.f));
                if (reset && rg == 0) { a = 0.f; mult = 1.f; }
                *(LAS float*)(L + L_A + (t * 128 + dl) * 4) = a; *(LAS float*)(L + L_B + (t * 128 + dl) * 4) = mult * ig; }
        }
        __syncthreads();
        { const int c = F.tid & 127, qq = F.tid >> 7, ch = n * 128 + c;
          float Pv[16], hv[16]; float P = 1.f, h = 0.f;
#pragma unroll
          for (int k = 0; k < 16; ++k) { const int t = 16 * qq + k;
              const float a = *(const LAS float*)(L + L_A + (t * 128 + c) * 4), bm = *(const LAS float*)(L + L_B + (t * 128 + c) * 4);
              const float xcv = bf2f(*(const LAS unsigned short*)(L + L_XC + LSWZ(t, c * 2)));
              h = fmaf(a, h, bm * xcv); P = a * P; Pv[k] = P; hv[k] = h; }
          LAS float* ag = (LAS float*)(L + L_AGG);
          ag[(qq * 128 + c) * 2] = P; ag[(qq * 128 + c) * 2 + 1] = h;
          __syncthreads();
          float Pin = 1.f, Hin = smp ? F.state_lru[(size_t)b * 1024 + ch] : 0.f;
          for (int q2 = 0; q2 < qq; ++q2) { const float Pq = ag[(q2 * 128 + c) * 2], Hq = ag[(q2 * 128 + c) * 2 + 1]; Hin = fmaf(Pq, Hin, Hq); Pin = Pq * Pin; }
          float hl = 0.f, Pl = 1.f;
#pragma unroll
          for (int k = 0; k < 16; ++k) { const size_t gi = (row0 + 16 * qq + k) * 1024 + ch;
              hl = fmaf(Pv[k], Hin, hv[k]); Pl = Pv[k] * Pin;
              const float G = gelu_tanh_f(bf2f(GL[gi])) * sigmoid_f(bf2f(GA[gi]));
              Y0[gi] = (bf16)f2bf(hl * G); Y1[gi] = (bf16)f2bf(Pl * G); }
          if (qq == 3) { if (smp) F.out[OUT_HS + (size_t)b * 1024 + ch] = hl;
                         else { float* ao = F.agg + (((size_t)(b * 8 + n) * NCHUNK + j) * 256); ao[c] = Pl; ao[128 + c] = hl; } }
        }
    }
    { const int gw = F.vcu * NWAVES + F.wave, NGW = F.G * NWAVES;
      const bf16* ZKb = zbuf(F, ZK); const bf16* ZVb = zbuf(F, ZV);
      for (int r = gw; r < 9216; r += NGW) {
          const bf16* src; float* dst;
          if (r < 8192) { const int isv = r >> 12, rr = r & 4095, b = rr >> 9, k = rr & 511; src = (isv ? ZVb : ZKb) + ((size_t)b * TP + (TP - CROWS) + k) * 1024; dst = F.out + (isv ? OUT_VP : OUT_KP) + (size_t)rr * 1024; }
          else { const int r2 = r - 8192, isv = r2 >> 9, rr = r2 & 511; src = (isv ? ZVb : ZKb) + ((size_t)MP + rr) * 1024; dst = F.out + (isv ? OUT_VS : OUT_KS) + (size_t)rr * 1024; }
#pragma unroll
          for (int hf = 0; hf < 2; ++hf) { const v4u raw = *(const v4u*)(src + hf * 512 + F.lane * 8); float* d = dst + hf * 512 + F.lane * 8;
              *(f32x4*)d = (f32x4){__uint_as_float(raw.x << 16), __uint_as_float(raw.x & 0xffff0000u), __uint_as_float(raw.y << 16), __uint_as_float(raw.y & 0xffff0000u)};
              *(f32x4*)(d + 4) = (f32x4){__uint_as_float(raw.z << 16), __uint_as_float(raw.z & 0xffff0000u), __uint_as_float(raw.w << 16), __uint_as_float(raw.w & 0xffff0000u)}; }
      } }
}
__device__ __forceinline__ void p4_attention(Frame& F, const bf16* Y0, const bf16* Y1, bf16* MG) {
    char* lds = (char*)F.lds;
    const int pair = F.vcu >> 2, quarter = F.vcu & 3, b = pair >> 3, h = pair & 7;
    const int wid = F.wave, lane = F.lane, r32 = lane & 31, hi = lane >> 5, wch = wid >> 1;
    { LAS float* tb = (LAS float*)(F.lds + attn::L_TB);
      for (int i = F.tid; i < 320; i += NWAVES * 64) tb[i] = F.rel_bias[h * 257 + (i < 256 ? i : 256)] * (1.0f / attn::SCALE);
      __syncthreads(); }
    const bf16* wsb = (const bf16*)F.ws;
    const bf16* ZQb = zbuf(F, ZQ); const bf16* ZGBb = zbuf(F, ZGB);
    const long offK = (long)((WS_Z + (size_t)ZK * ZBUF) / 2), offV = (long)((WS_Z + (size_t)ZV * ZBUF) / 2), offCK = (long)(WS_CK / 2), offCV = (long)(WS_CV / 2);
    const float* ag = F.agg + ((size_t)(b * 8 + h) * NCHUNK) * 256;
    float hin[4] = {0.f, 0.f, 0.f, 0.f};
    for (int c = 0; c < 32 * quarter; ++c) {
#pragma unroll
        for (int d0 = 0; d0 < 4; ++d0) hin[d0] = fmaf(ag[c * 256 + 32 * d0 + r32], hin[d0], ag[c * 256 + 128 + 32 * d0 + r32]); }
    LAS float* hsl = (LAS float*)(F.lds + attn::L_HIN) + F.tid * 4;
#pragma unroll
    for (int d0 = 0; d0 < 4; ++d0) hsl[d0] = hin[d0];
    const int nunits = 8 + (quarter == 0 ? 1 : 0);
    for (int ui = 0; ui < nunits; ++ui) {
        const bool smp = ui >= 8; const int g = 8 * quarter + ui;
        attn::AUnit u; u.wsb = wsb;
        size_t row0;
        if (!smp) { row0 = (size_t)b * TP + 256 * g;
            u.kA = offK + ((long)b * TP + (long)(4 * g - 8) * 64) * 1024 + h * 128; u.vA = offV + ((long)b * TP + (long)(4 * g - 8) * 64) * 1024 + h * 128;
            u.kB = u.kA; u.vB = u.vA; u.tsw = 1 << 30; u.t0 = (8 - 4 * g) > 0 ? (8 - 4 * g) : 0; u.nt = 12; u.nwq = 8; }
        else { row0 = (size_t)MP + b * 64;
            u.kA = offCK + ((long)b * CROWS) * 1024 + h * 128; u.vA = offCV + ((long)b * CROWS) * 1024 + h * 128;
            u.kB = offK + ((long)MP + b * 64) * 1024 + h * 128; u.vB = offV + ((long)MP + b * 64) * 1024 + h * 128; u.tsw = 8; u.t0 = 0; u.nt = 10; u.nwq = 2; }
        u.q = ZQb + row0 * 1024 + h * 128;
        attn::f32x16 o[4]; float rli[16];
        attn::attn_unit(u, lds, o, rli);
        float hw[4];
#pragma unroll
        for (int d0 = 0; d0 < 4; ++d0) hw[d0] = smp ? 0.f : hsl[d0];
        if (!smp) for (int c = 0; c < wch; ++c) {
#pragma unroll
            for (int d0 = 0; d0 < 4; ++d0) hw[d0] = fmaf(ag[(4 * g + c) * 256 + 32 * d0 + r32], hw[d0], ag[(4 * g + c) * 256 + 128 + 32 * d0 + r32]); }
        if (wid < u.nwq) {
        int hi_l = hi; asm volatile("" : "+v"(hi_l));
#pragma unroll
        for (int r = 0; r < 16; ++r) { const size_t row = row0 + 32 * wid + attn::crow(r, hi_l);
#pragma unroll
            for (int d0 = 0; d0 < 4; ++d0) { const size_t gi = row * 1024 + h * 128 + 32 * d0 + r32;
                const float val = bf2f(Y0[gi]) + bf2f(Y1[gi]) * hw[d0] + sigmoid_f(bf2f(ZGBb[gi])) * (o[d0][r] * rli[r]);
                MG[gi] = (bf16)f2bf(val); } } }
        if (!smp) {
            float hn[4];
#pragma unroll
            for (int d0 = 0; d0 < 4; ++d0) hn[d0] = hsl[d0];
            for (int c = 0; c < 4; ++c) {
#pragma unroll
                for (int d0 = 0; d0 < 4; ++d0) hn[d0] = fmaf(ag[(4 * g + c) * 256 + 32 * d0 + r32], hn[d0], ag[(4 * g + c) * 256 + 128 + 32 * d0 + r32]); }
#pragma unroll
            for (int d0 = 0; d0 < 4; ++d0) hsl[d0] = hn[d0];
            if (g == 31 && wid == 0 && hi == 0) {
#pragma unroll
                for (int d0 = 0; d0 < 4; ++d0) F.out[OUT_HP + (size_t)b * 1024 + h * 128 + 32 * d0 + r32] = hn[d0]; }
        }
    }
}

struct Args { const float* in[28]; float* out; unsigned char* ws; int ph_lo, ph_hi, li, pad; };
__global__ void __launch_bounds__(NWAVES * 64, 2) mega_fwd(Args args) {
    extern __shared__ __attribute__((aligned(16))) unsigned char lds[];
    Frame F;
    F.lds = (LAS unsigned char*)lds;
    F.MISC = (volatile LAS unsigned*)(F.lds + MISC_OFF);
    F.tid = threadIdx.x; F.lane = F.tid & 63; F.wave = __builtin_amdgcn_readfirstlane(F.tid >> 6);
    F.G = gridDim.x; { const int bx = blockIdx.x; F.vcu = (F.G % 8 == 0) ? (bx % 8) * (F.G / 8) + bx / 8 : bx; }
    unsigned char* ws = args.ws; F.ws = ws; F.out = args.out;
    F.ctl = (gu32*)(ws + WS_CTL);
    F.x_p = args.in[0]; F.x_s = args.in[1]; F.c_p = args.in[2]; F.c_s = args.in[3]; F.cache_k = args.in[4]; F.cache_v = args.in[5]; F.state_conv = args.in[6]; F.state_lru = args.in[7];
    F.w_ada = args.in[8]; F.b_ada = args.in[9]; F.w_in = args.in[10]; F.conv_w = args.in[11]; F.conv_b = args.in[12]; F.w_rg = args.in[13]; F.b_rg = args.in[14]; F.w_ig = args.in[15]; F.b_ig = args.in[16];
    F.lam = args.in[17]; F.rel_bias = args.in[18]; F.w_out = args.in[19]; F.ln1_g = args.in[20]; F.ln1_b = args.in[21]; F.w_up = args.in[22]; F.b_up = args.in[23]; F.w_down = args.in[24]; F.b_down = args.in[25];
    F.ln2_g = args.in[26]; F.ln2_b = args.in[27];
    F.mod = (float*)(ws + WS_MOD); F.agg = (float*)(ws + WS_AGG);
    F.Win_t = (bf16*)(ws + WS_WIN); F.Wout_t = (bf16*)(ws + WS_WOUT); F.Wup_t = (bf16*)(ws + WS_WUP); F.Wdn_t = (bf16*)(ws + WS_WDN); F.Wrg_t = (bf16*)(ws + WS_WRG); F.Wig_t = (bf16*)(ws + WS_WIG);
    F.CK = (bf16*)(ws + WS_CK); F.CV = (bf16*)(ws + WS_CV); F.Z = (bf16*)(ws + WS_Z);
    for (int u = F.tid; u < (LDS_BYTES - LDSCTL_OFF) / 4; u += NWAVES * 64) ((LAS unsigned*)(F.lds + LDSCTL_OFF))[u] = 0u;
    __syncthreads();
    XcdBarrier bar; bar.bar = (unsigned*)(F.ctl + CW_BAR); bar.x = 0; bar.st = nullptr;
    if (N_LAUNCHES == 1) bar = xcd_barrier_post((unsigned*)(F.ctl + CW_BAR), F.MISC + 8);
#define GRID_BAR() do { if (N_LAUNCHES == 1) xcd_barrier(bar); } while (0)
    const int lo = args.ph_lo, hi = args.ph_hi;
#ifndef MK_PHASE_MASK
#define MK_PHASE_MASK 0x3ff
#endif
#define IN(k) (((MK_PHASE_MASK >> (k)) & 1) && lo <= (k) && (k) < hi)
#define BOTH(k) (IN(k) && IN((k) + 1))
#define REP(k) ((MK_REPEAT_PHASE == (k)) ? 2 : 1)
    bf16* U = (bf16*)F.out; bf16* Y0 = (bf16*)F.out; bf16* Y1 = (bf16*)((unsigned char*)F.out + ZBUF); float* R = F.out;
    bf16* MG = (bf16*)(ws + WS_MERGED); bf16* U2 = (bf16*)(ws + WS_U2); float* X1 = (float*)(ws + WS_X1); bf16* HB = (bf16*)(ws + WS_H);

    if (IN(0)) { for (int rep = 0; rep < REP(0); ++rep) { p0_prologue(F); __syncthreads(); } if (BOTH(0)) GRID_BAR(); }
    if (IN(1)) { for (int rep = 0; rep < REP(1); ++rep) p1_upass(F, U); if (BOTH(1)) GRID_BAR(); }
    if (IN(2)) {
        for (int rep = 0; rep < REP(2); ++rep) {
        pg8::Gemm g{U, F.Win_t, M, DIN, DM}; pg8::StaticOrder S; S.init(M, DIN, F.G, (int)blockIdx.x);
        pg8::EpiBf16<0> E{F.Z, 1024, nullptr, 1024, ZBUF / 2, 1.f};
        pg8::gemm_phase<pg8::EpiBf16<0>, pg8::StaticOrder, PG8_ALIGN, PG8_SP2>(F.lds + RING_OFF, g, S, E); }
        if (BOTH(2)) GRID_BAR();
    }
    if (IN(3)) { for (int rep = 0; rep < REP(3); ++rep) { p3_lru(F, Y0, Y1); __syncthreads(); } if (BOTH(3)) GRID_BAR(); }
    if (IN(4)) { for (int rep = 0; rep < REP(4); ++rep) { p4_attention(F, Y0, Y1, MG); __syncthreads(); } if (BOTH(4)) GRID_BAR(); }
    if (IN(5)) {
        for (int rep = 0; rep < REP(5); ++rep) {
        pg8::Gemm g{MG, F.Wout_t, M, DM, DM}; pg8::StaticOrder S; S.init(M, DM, F.G, (int)blockIdx.x);
        pg8::EpiRes E{F.x_p, F.x_s, R, nullptr, F.mod, MOD_G1, MP, ALPHA};
        pg8::gemm_phase<pg8::EpiRes, pg8::StaticOrder, PG8_ALIGN, PG8_SP2>(F.lds + RING_OFF, g, S, E); }
        if (BOTH(5)) GRID_BAR();
    }
    if (IN(6)) { for (int rep = 0; rep < REP(6); ++rep) ln_pass<true>(F, R, X1, U2, F.ln1_g, F.ln1_b); if (BOTH(6)) GRID_BAR(); }
    if (IN(7)) {
        for (int rep = 0; rep < REP(7); ++rep) {
        pg8::Gemm g{U2, F.Wup_t, M, FF, DM}; pg8::StaticOrder S; S.init(M, FF, F.G, (int)blockIdx.x);
        pg8::EpiBf16<2> E{HB, FF, F.b_up, 0, 0, 1.f};
        pg8::gemm_phase<pg8::EpiBf16<2>, pg8::StaticOrder, PG8_ALIGN, PG8_SP2>(F.lds + RING_OFF, g, S, E); }
        if (BOTH(7)) GRID_BAR();
    }
    if (IN(8)) {
        for (int rep = 0; rep < REP(8); ++rep) {
        pg8::Gemm g{HB, F.Wdn_t, M, DM, FF}; pg8::StaticOrder S; S.init(M, DM, F.G, (int)blockIdx.x);
        pg8::EpiRes E{X1, X1 + (size_t)MP * 1024, R, F.b_down, F.mod, MOD_G2, MP, ALPHA};
        pg8::gemm_phase<pg8::EpiRes, pg8::StaticOrder, PG8_ALIGN, PG8_SP2>(F.lds + RING_OFF, g, S, E); }
        if (BOTH(8)) GRID_BAR();
    }
    if (IN(9)) { ln_pass<false>(F, R, R, nullptr, F.ln2_g, F.ln2_b); }
#undef IN
#undef BOTH
#undef REP
}

extern "C" void kernel_launch(void* const* d_in, const int* in_sizes, int n_in, void* d_out, int out_size, void* d_ws, size_t ws_size, hipStream_t stream) {
    static int grid = 0;
    if (grid == 0) {
        if (n_in != 28 || in_sizes[0] != MP * DM || in_sizes[1] != MS * DM || (size_t)out_size != OUT_TOTAL || ws_size < WS_END) {
            fprintf(stderr, "kernel_launch: built for 28 inputs, x_prompt %d, out %zu floats, >= %zu bytes of workspace; got n_in %d, in0 %d, out %d, ws %zu; nothing launched\n", MP * DM, (size_t)OUT_TOTAL, (size_t)WS_END, n_in, n_in > 0 ? in_sizes[0] : -1, out_size, ws_size); grid = -1; return; }
        int dev = 0, cus = 0, per_cu = 0;
        if (hipGetDevice(&dev) != hipSuccess || hipDeviceGetAttribute(&cus, hipDeviceAttributeMultiprocessorCount, dev) != hipSuccess) { fprintf(stderr, "kernel_launch: hipGetDevice / hipDeviceGetAttribute failed\n"); grid = -1; return; }
        if (hipFuncSetAttribute((const void*)mega_fwd, hipFuncAttributeMaxDynamicSharedMemorySize, LDS_BYTES) != hipSuccess) { fprintf(stderr, "kernel_launch: hipFuncSetAttribute(%d B LDS) failed\n", LDS_BYTES); grid = -1; return; }
        if (hipOccupancyMaxActiveBlocksPerMultiprocessor(&per_cu, (const void*)mega_fwd, NWAVES * 64, LDS_BYTES) != hipSuccess || per_cu < 1)
            fprintf(stderr, "kernel_launch: note: occupancy query reports %d workgroups per CU\n", per_cu);
        (void)hipGetLastError();
        grid = cus;
        if (grid != 256) { fprintf(stderr, "kernel_launch: this kernel is built for a 256-CU device (got %d)\n", grid); grid = -1; return; }
    }
    if (grid < 0) return;
    if (hipMemsetAsync((char*)d_ws + WS_CTL, 0, CTL_ZERO_BYTES, stream) != hipSuccess) { fprintf(stderr, "kernel_launch: hipMemsetAsync failed\n"); return; }
    Args a{};
    for (int i = 0; i < 28; ++i) a.in[i] = (const float*)d_in[i];
    a.out = (float*)d_out; a.ws = (unsigned char*)d_ws;
    for (int li = 0; li < N_LAUNCHES; ++li) {
        a.ph_lo = (N_LAUNCHES == 1) ? 0 : li; a.ph_hi = (N_LAUNCHES == 1) ? N_PHASES : li + 1; a.li = li;
        hipLaunchKernelGGL(mega_fwd, dim3(grid), dim3(NWAVES * 64), LDS_BYTES, stream, a);
        const hipError_t le = hipPeekAtLastError();
        if (le != hipSuccess) { fprintf(stderr, "kernel_launch: launch %d failed: %s\n", li, hipGetErrorName(le)); break; }
    }
}
```

```cpp
#include <hip/hip_runtime.h>
#include <hip/hip_bf16.h>
#include <cstdio>
#include <cstdint>
#include <cmath>

namespace pg8 {
#define PG8_LAS __attribute__((address_space(3)))
typedef unsigned short bf16_t;
typedef short bf16x8 __attribute__((ext_vector_type(8)));
typedef float f32x4 __attribute__((ext_vector_type(4)));
typedef unsigned u32x4 __attribute__((ext_vector_type(4)));
constexpr int BM = 256, BK = 64, HALF = 128, HTB = HALF * BK * 2  , STAGE_BYTES = 8 * HTB, NXCD = 8, WGM = 8;

__host__ __device__ __forceinline__ int lds_byte(int r, int c) { const int st = (r >> 4) * 2 + (c >> 5), rr = r & 15, cc = c & 31, ob = rr * 64 + cc * 2; return st * 1024 + (ob ^ (((ob >> 9) & 1) << 5)); }
__host__ __device__ __forceinline__ void stage_rc(int b, int& R, int& C) { const int st = b / 1024, sb = b % 1024, swz = sb ^ (((sb >> 9) & 1) << 5); R = (st >> 1) * 16 + swz / 64; C = (st & 1) * 32 + (swz % 64) / 2; }
__host__ __device__ __forceinline__ int perm32(int rho) { const int n = rho >> 4, i = rho & 15; return 8 * (i >> 2) + 4 * n + (i & 3); }

struct Unit { int pm, pn; };
struct Gemm { const bf16_t* A; const bf16_t* Bt; int M, N, K; };

struct StaticOrder {
    int nM, nN, nwg, G, c;
    __host__ __device__ void init(int M, int N, int G_, int c_) { nM = M / BM; nN = N / BM; nwg = nM * nN; G = G_; c = c_; }
    __host__ __device__ bool next(int i, Unit& u) const {
        const long L = (long)i * G + c; if (L >= nwg) return false;
        int wgid = (int)L; { const int q = nwg / NXCD, r = nwg % NXCD, xcd = wgid % NXCD, off = wgid / NXCD; wgid = (xcd < r ? xcd * (q + 1) : r * (q + 1) + (xcd - r) * q) + off; }
        const int nig = WGM * nN, gid = wgid / nig, fm = gid * WGM, gsz = (nM - fm) < WGM ? (nM - fm) : WGM;
        u.pm = fm + ((wgid % nig) % gsz); u.pn = (wgid % nig) / gsz; return true;
    }
    __device__ __forceinline__ void a_ready(const Unit&) const {}
    __device__ __forceinline__ void done(const Unit&) const {}
};

__device__ __forceinline__ unsigned cvt_pk_bf16(float lo, float hi) { unsigned r; asm volatile("v_cvt_pk_bf16_f32 %0, %1, %2" : "=v"(r) : "v"(lo), "v"(hi)); return r; }
typedef float f32x2 __attribute__((ext_vector_type(2)));
__device__ __forceinline__ f32x2 gelu_pk(f32x2 v) {
    const f32x2 av = __builtin_elementwise_abs(v), d = av * 0.2316418882f + 1.0f;
    f32x2 t; t.x = __builtin_amdgcn_rcpf(d.x); t.y = __builtin_amdgcn_rcpf(d.y);
    f32x2 q = t * 0.5307027145f + (-0.7265760135f); q = q * t + 0.7107068705f; q = q * t + (-0.142248368f); q = q * t + 0.127414796f; q = q * t;
    const f32x2 s = (v * v) * (-0.72134752044f);
    f32x2 e; e.x = __builtin_amdgcn_exp2f(s.x); e.y = __builtin_amdgcn_exp2f(s.y);
    const f32x2 m = v * (q * e), r = v - m;
    f32x2 o; o.x = v.x < 0.f ? m.x : r.x; o.y = v.y < 0.f ? m.y : r.y; return o;
}

template <int ACT  > struct EpiBf16 {
    static constexpr bool PERM = true, AFTER_DRAIN = false; static_assert(ACT == 0 || ACT == 1 || ACT == 2, "EpiBf16: ACT is 0 (none), 1 (gelu_pk) or 2 (relu squared)");
    bf16_t* O; int ldc; const float* bias; int split_cols; size_t split_stride; float scale0;
    __device__ __forceinline__ void operator()(const f32x4 (&acc)[2][2][4][2], const Unit& u, int wr, int wc, int fr, int fq) const {
        const int row0 = u.pm * BM + wr * 64 + fr; int colt = u.pn * BM; bf16_t* base = O;
        float sc = 1.f; if (split_cols) { const int t = colt / split_cols; base += (size_t)t * split_stride; colt -= t * split_cols; if (t == 0) sc = scale0; }
        const int col0 = colt + wc * 32 + 8 * fq, bcol0 = u.pn * BM + wc * 32 + 8 * fq;
        f32x4 bv[2][2];
#pragma unroll
        for (int bj = 0; bj < 2; ++bj)
#pragma unroll
            for (int n = 0; n < 2; ++n) bv[bj][n] = bias ? *(const f32x4*)(bias + bcol0 + bj * HALF + 4 * n) : (f32x4){0.f, 0.f, 0.f, 0.f};
#pragma unroll
        for (int ai = 0; ai < 2; ++ai)
#pragma unroll
            for (int m = 0; m < 4; ++m) { bf16_t* rowp = base + (size_t)(row0 + ai * HALF + m * 16) * ldc + col0;
#pragma unroll
                for (int bj = 0; bj < 2; ++bj) { f32x4 v0 = acc[ai][bj][m][0] + bv[bj][0], v1 = acc[ai][bj][m][1] + bv[bj][1];
                    if (ACT == 1) { f32x2 a = gelu_pk((f32x2){v0[0], v0[1]}), b = gelu_pk((f32x2){v0[2], v0[3]}), c = gelu_pk((f32x2){v1[0], v1[1]}), d = gelu_pk((f32x2){v1[2], v1[3]});
                        v0 = (f32x4){a.x, a.y, b.x, b.y}; v1 = (f32x4){c.x, c.y, d.x, d.y}; }
                    if (ACT == 2) { _Pragma("unroll") for (int e_ = 0; e_ < 4; ++e_) { const float a_ = fmaxf(v0[e_], 0.f), b_ = fmaxf(v1[e_], 0.f); v0[e_] = a_ * a_; v1[e_] = b_ * b_; } }
                    v0 = v0 * sc; v1 = v1 * sc; u32x4 w; w.x = cvt_pk_bf16(v0[0], v0[1]); w.y = cvt_pk_bf16(v0[2], v0[3]); w.z = cvt_pk_bf16(v1[0], v1[1]); w.w = cvt_pk_bf16(v1[2], v1[3]);
                    *(u32x4*)(rowp + bj * HALF) = w; } }
    }
};


struct EpiRes {
    static constexpr bool PERM = false, AFTER_DRAIN = false;
    const float* xin_p; const float* xin_s; float* out; const float* bias; const float* mod; int goff; int mp; float alpha;
    __device__ __forceinline__ void operator()(const f32x4 (&acc)[2][2][4][2], const Unit& u, int wr, int wc, int fr, int fq) const {
        const int col0 = u.pn * BM + wc * 32 + 4 * fq;
        f32x4 bv[2][2];
#pragma unroll
        for (int bj = 0; bj < 2; ++bj)
#pragma unroll
            for (int n = 0; n < 2; ++n) bv[bj][n] = bias ? *(const f32x4*)(bias + col0 + bj * HALF + n * 16) : (f32x4){0.f, 0.f, 0.f, 0.f};
#pragma unroll
        for (int ai = 0; ai < 2; ++ai) {
            const int rowbase = u.pm * BM + ai * HALF + wr * 64;
            const int bidx = rowbase < mp ? (rowbase >> 13) : 8 + ((rowbase - mp) >> 6);
            const float* gp = mod + (size_t)bidx * 6144 + goff + col0;
            f32x4 gv[2][2];
#pragma unroll
            for (int bj = 0; bj < 2; ++bj)
#pragma unroll
                for (int n = 0; n < 2; ++n) gv[bj][n] = *(const f32x4*)(gp + bj * HALF + n * 16) + 1.0f;
#pragma unroll
            for (int m = 0; m < 4; ++m) {
                const int row = rowbase + m * 16 + fr;
                const float* xrow = (row < mp ? xin_p + (size_t)row * 1024 : xin_s + (size_t)(row - mp) * 1024) + col0;
                float* orow = out + (size_t)row * 1024 + col0;
#pragma unroll
                for (int bj = 0; bj < 2; ++bj)
#pragma unroll
                    for (int n = 0; n < 2; ++n) {
                        const f32x4 xv = *(const f32x4*)(xrow + bj * HALF + n * 16);
                        const f32x4 o = xv * alpha + gv[bj][n] * (acc[ai][bj][m][n] + bv[bj][n]);
                        *(f32x4*)(orow + bj * HALF + n * 16) = o;
                    }
                if (m & 1) asm volatile("" ::: "memory");
            }
        }
    }
};

template <class Epi, class Sched, bool ALIGN_EPI = false, bool SP2 = false>
__device__ __forceinline__ void gemm_phase(PG8_LAS unsigned char* lds, const Gemm g, const Sched& S, const Epi& E) {
    const int tid = threadIdx.x, wid = __builtin_amdgcn_readfirstlane(tid >> 6), lane = tid & 63, wr = wid >> 2, wc = wid & 3, fr = lane & 15, fq = lane >> 4;
    const int K = g.K, nt = K / BK;
    unsigned voffA[2], voffB[2];
#pragma unroll
    for (int i = 0; i < 2; ++i) { int R, C; stage_rc(tid * 16 + i * 8192, R, C); const int Rb = Epi::PERM ? ((R & ~31) + perm32(R & 31)) : R;
        voffA[i] = (unsigned)(R * K + C) * 2u; voffB[i] = (unsigned)(Rb * K + C) * 2u; }
    const size_t kstep = (size_t)(BK * 2);
    const size_t hstep = (size_t)HALF * K * 2;
    const size_t tstep = 2 * hstep;
    const unsigned ldsw = (unsigned)wid * 1024u;
    const int aoff = lds_byte(wr * 64 + fr, fq * 8), boff = lds_byte(wc * 32 + fr, fq * 8);
#define PG8_SA(b, h) (((b) * 2 + (h)) * HTB)
#define PG8_SB(b, h) ((4 + (b) * 2 + (h)) * HTB)
#define PG8_STAGE(bufoff, gbase, voff) do { _Pragma("unroll") for (int _i = 0; _i < 2; ++_i) \
        __builtin_amdgcn_global_load_lds((const unsigned*)((const char*)(gbase) + (voff)[_i]), (PG8_LAS unsigned*)(lds + (bufoff) + ldsw + _i * 8192), 16, 0, 0); } while (0)
#define PG8_LDA(dst, b, h) do { _Pragma("unroll") for (int m = 0; m < 4; ++m) _Pragma("unroll") for (int k = 0; k < 2; ++k) dst[m][k] = *(const PG8_LAS bf16x8*)(lds + PG8_SA(b, h) + aoff + m * 2048 + k * 1024); } while (0)
#define PG8_LDB(dst, b, h) do { _Pragma("unroll") for (int n = 0; n < 2; ++n) _Pragma("unroll") for (int k = 0; k < 2; ++k) dst[n][k] = *(const PG8_LAS bf16x8*)(lds + PG8_SB(b, h) + boff + n * 2048 + k * 1024); } while (0)
#define PG8_MMA(ai, bj, At, Bt) do { __builtin_amdgcn_s_setprio(1); _Pragma("unroll") for (int m = 0; m < 4; ++m) _Pragma("unroll") for (int n = 0; n < 2; ++n) _Pragma("unroll") for (int k = 0; k < 2; ++k) \
        acc[ai][bj][m][n] = __builtin_amdgcn_mfma_f32_16x16x32_bf16(Bt[n][k], At[m][k], acc[ai][bj][m][n], 0, 0, 0); __builtin_amdgcn_s_setprio(0); } while (0)
#define PG8_WAIT_V(n) asm volatile("s_waitcnt vmcnt(" #n ")" ::: "memory")
#define PG8_WAIT_L(n) asm volatile("s_waitcnt lgkmcnt(" #n ")" ::: "memory")
#define PG8_BAR __builtin_amdgcn_s_barrier()
#define PG8_SCHED __builtin_amdgcn_sched_barrier(0)
    Unit cur, nxt; int ui = 0;
    if (!S.next(0, cur)) return;
    f32x4 acc[2][2][4][2];
#pragma unroll
    for (int a = 0; a < 2; ++a)
#pragma unroll
        for (int b = 0; b < 2; ++b)
#pragma unroll
            for (int m = 0; m < 4; ++m)
#pragma unroll
                for (int n = 0; n < 2; ++n) acc[a][b][m][n] = (f32x4){0.f, 0.f, 0.f, 0.f};
    bf16x8 At[4][2], B0[2][2], B1[2][2];
    const char* cA = (const char*)g.A + (size_t)cur.pm * tstep; const char* cB = (const char*)g.Bt + (size_t)cur.pn * tstep;
    S.a_ready(cur);
    if constexpr (SP2) {
        PG8_STAGE(PG8_SB(0, 0), cB, voffB); PG8_STAGE(PG8_SB(0, 1), cB + hstep, voffB); PG8_STAGE(PG8_SA(0, 0), cA, voffA); PG8_STAGE(PG8_SA(0, 1), cA + hstep, voffA);
        if (wr == 1) PG8_BAR;
        PG8_WAIT_V(2); PG8_BAR;
        PG8_STAGE(PG8_SB(1, 0), cB + kstep, voffB); PG8_STAGE(PG8_SA(1, 0), cA + kstep, voffA); PG8_STAGE(PG8_SB(1, 1), cB + hstep + kstep, voffB);
        PG8_WAIT_V(6); PG8_BAR;
    } else {
        PG8_STAGE(PG8_SB(0, 0), cB, voffB); PG8_STAGE(PG8_SA(0, 0), cA, voffA); PG8_STAGE(PG8_SB(0, 1), cB + hstep, voffB); PG8_STAGE(PG8_SA(0, 1), cA + hstep, voffA);
        if (wr == 1) PG8_BAR;
        PG8_WAIT_V(4); PG8_BAR;
        PG8_STAGE(PG8_SB(1, 0), cB + kstep, voffB); PG8_STAGE(PG8_SA(1, 0), cA + kstep, voffA); PG8_STAGE(PG8_SB(1, 1), cB + hstep + kstep, voffB);
        PG8_WAIT_V(6); PG8_BAR;
    }
    for (;;) {
        const bool has_next = S.next(ui + 1, nxt);
        const char* nA = has_next ? (const char*)g.A + (size_t)nxt.pm * tstep : cA; const char* nB = has_next ? (const char*)g.Bt + (size_t)nxt.pn * tstep : cB;
        for (int t = 0; t < nt; t += 2) {
            const bool last = (t == nt - 2);
            const char* a1 = cA + (size_t)(t + 1) * kstep;
            const char* a2 = last ? nA : cA + (size_t)(t + 2) * kstep; const char* b2 = last ? nB : cB + (size_t)(t + 2) * kstep;
            const char* a3 = a2 + kstep; const char* b3 = b2 + kstep;
            if (last && has_next) S.a_ready(nxt);
            if constexpr (SP2) {
            PG8_LDB(B0, 0, 0); PG8_LDB(B1, 0, 1); PG8_SCHED; PG8_LDA(At, 0, 0); PG8_STAGE(PG8_SA(1, 1), a1 + hstep, voffA);
            PG8_WAIT_V(8); PG8_WAIT_L(0); PG8_BAR; PG8_MMA(0, 0, At, B0); PG8_MMA(0, 1, At, B1); PG8_BAR; PG8_SCHED;
            PG8_LDA(At, 0, 1); PG8_STAGE(PG8_SB(0, 0), b2, voffB); PG8_STAGE(PG8_SB(0, 1), b2 + hstep, voffB); PG8_STAGE(PG8_SA(0, 0), a2, voffA);
            PG8_WAIT_V(8); PG8_WAIT_L(0); PG8_BAR; PG8_MMA(1, 0, At, B0); PG8_MMA(1, 1, At, B1); PG8_BAR; PG8_SCHED;
            PG8_LDB(B0, 1, 0); PG8_LDB(B1, 1, 1); PG8_SCHED; PG8_LDA(At, 1, 0); PG8_STAGE(PG8_SA(0, 1), a2 + hstep, voffA);
            PG8_WAIT_V(8); PG8_WAIT_L(0); PG8_BAR; PG8_MMA(0, 0, At, B0); PG8_MMA(0, 1, At, B1); PG8_BAR; PG8_SCHED;
            PG8_LDA(At, 1, 1); PG8_STAGE(PG8_SB(1, 0), b3, voffB); PG8_STAGE(PG8_SB(1, 1), b3 + hstep, voffB); PG8_STAGE(PG8_SA(1, 0), a3, voffA);
            PG8_WAIT_V(8); PG8_WAIT_L(0); PG8_BAR; PG8_MMA(1, 0, At, B0); PG8_MMA(1, 1, At, B1); PG8_BAR; PG8_SCHED;
            } else {
            PG8_LDB(B0, 0, 0); PG8_SCHED; PG8_LDA(At, 0, 0); PG8_STAGE(PG8_SA(1, 1), a1 + hstep, voffA);
            PG8_WAIT_L(8); PG8_BAR; PG8_WAIT_L(0); PG8_MMA(0, 0, At, B0); PG8_BAR; PG8_SCHED;
            PG8_LDB(B1, 0, 1); PG8_STAGE(PG8_SB(0, 0), b2, voffB);
            PG8_BAR; PG8_WAIT_L(0); PG8_MMA(0, 1, At, B1); PG8_BAR;
            PG8_LDA(At, 0, 1); PG8_STAGE(PG8_SA(0, 0), a2, voffA);
            PG8_BAR; PG8_WAIT_L(0); PG8_MMA(1, 0, At, B0); PG8_BAR; PG8_SCHED;
            PG8_STAGE(PG8_SB(0, 1), b2 + hstep, voffB);
            PG8_WAIT_V(6); PG8_BAR; PG8_MMA(1, 1, At, B1); PG8_BAR;
            PG8_LDB(B0, 1, 0); PG8_SCHED; PG8_LDA(At, 1, 0); PG8_STAGE(PG8_SA(0, 1), a2 + hstep, voffA);
            PG8_WAIT_L(8); PG8_BAR; PG8_WAIT_L(0); PG8_MMA(0, 0, At, B0); PG8_BAR; PG8_SCHED;
            PG8_LDB(B1, 1, 1); PG8_STAGE(PG8_SB(1, 0), b3, voffB);
            PG8_BAR; PG8_WAIT_L(0); PG8_MMA(0, 1, At, B1); PG8_BAR;
            PG8_LDA(At, 1, 1); PG8_STAGE(PG8_SA(1, 0), a3, voffA);
            PG8_BAR; PG8_WAIT_L(0); PG8_MMA(1, 0, At, B0); PG8_BAR; PG8_SCHED;
            PG8_STAGE(PG8_SB(1, 1), b3 + hstep, voffB);
            PG8_WAIT_V(6); PG8_BAR; PG8_MMA(1, 1, At, B1); PG8_BAR;
            }
        }
        if constexpr (ALIGN_EPI) { if (wr == 0) PG8_BAR; }
        if constexpr (!Epi::AFTER_DRAIN) { E(acc, cur, wr, wc, fr, fq); S.done(cur); }
        if (!has_next) break;
#pragma unroll
        for (int a = 0; a < 2; ++a)
#pragma unroll
            for (int b = 0; b < 2; ++b)
#pragma unroll
                for (int m = 0; m < 4; ++m)
#pragma unroll
                    for (int n = 0; n < 2; ++n) acc[a][b][m][n] = (f32x4){0.f, 0.f, 0.f, 0.f};
        cur = nxt; cA = nA; cB = nB; ++ui;
        if constexpr (ALIGN_EPI) { if (wr == 1) PG8_BAR; }
    }
    PG8_WAIT_V(0);
    if constexpr (!ALIGN_EPI) { if (wr == 0) PG8_BAR; }
    PG8_BAR;
    if constexpr (Epi::AFTER_DRAIN) { E.fused(acc, cur, wr, wc, fr, fq, lds, wid, lane); S.done(cur); }
#undef PG8_SA
#undef PG8_SB
#undef PG8_STAGE
#undef PG8_LDA
#undef PG8_LDB
#undef PG8_MMA
#undef PG8_WAIT_V
#undef PG8_WAIT_L
#undef PG8_BAR
#undef PG8_SCHED
}
}


#ifndef PG8_SP2
#define PG8_SP2 true
#endif
#ifndef PG8_ALIGN
#define PG8_ALIGN true
#endif


namespace attn {
using bf16 = unsigned short;
using bf16x8 = __attribute__((ext_vector_type(8))) short;
using s16x4  = __attribute__((ext_vector_type(4))) short;
using f32x16 = __attribute__((ext_vector_type(16))) float;
using u32x4  = __attribute__((ext_vector_type(4))) unsigned;
constexpr int D = 128, NW = 8, QBLK = 32, KVBLK = 64;
constexpr float SCALE = 0.088388347648318440f;
constexpr float THR = 8.f;
constexpr int SHM_V = KVBLK * D * 2, SHM_K = KVBLK * D * 2;
constexpr int L_V = 0, L_K = 2 * SHM_V, L_WS = 2 * SHM_V + 2 * SHM_K, L_TB = L_WS + NW * 64 * 4, L_HIN = L_TB + 1280, ATTN_LDS = L_HIN + 8192;
constexpr long TILE_ELEMS = (long)KVBLK * 1024;
#define KSWZ(row, colB) ((row) * 256 + ((colB) ^ (((row) & 7) << 4)))
#define SBAR() __builtin_amdgcn_sched_barrier(0)
__device__ __forceinline__ int crow(int r, int hi) { return (r & 3) + 8 * (r >> 2) + 4 * hi; }
__device__ __forceinline__ unsigned cvtpk(float lo, float hi) { unsigned r; asm volatile("v_cvt_pk_bf16_f32 %0, %1, %2" : "=v"(r) : "v"(lo), "v"(hi)); return r; }
__device__ __forceinline__ float bf2f(unsigned short v) { return __uint_as_float(((unsigned)v) << 16); }

__device__ __forceinline__ void partialSM(f32x16& p0, f32x16& p1, float& m_reg, float& mn, float& alpha) {
  constexpr float C = SCALE * 1.4426950408889634f;
  float pmax = p0[0];
#pragma unroll
  for (int r = 1; r < 16; ++r) pmax = fmaxf(pmax, p0[r]);
#pragma unroll
  for (int r = 0; r < 16; ++r) pmax = fmaxf(pmax, p1[r]);
  { auto rr = __builtin_amdgcn_permlane32_swap(__float_as_uint(pmax), __float_as_uint(pmax), false, false);
    pmax = fmaxf(__uint_as_float(rr[0]), __uint_as_float(rr[1])); }
  if (__builtin_expect(__all(pmax - m_reg <= THR / SCALE), 1)) { mn = m_reg; alpha = 1.f; }
  else { mn = fmaxf(m_reg, pmax); alpha = __builtin_amdgcn_exp2f((m_reg - mn) * C); m_reg = mn; }
  float mnC = -mn * C;
#pragma unroll
  for (int r = 0; r < 16; ++r) p0[r] = fmaf(p0[r], C, mnC);
#pragma unroll
  for (int r = 0; r < 16; ++r) p1[r] = fmaf(p1[r], C, mnC);
#pragma unroll
  for (int r = 0; r < 16; ++r) p0[r] = __builtin_amdgcn_exp2f(p0[r]);
}
__device__ __forceinline__ void finishSM(f32x16& p0, f32x16& p1, float alpha, float& l_reg, bf16x8& pa0, bf16x8& pa1, bf16x8& pa2, bf16x8& pa3) {
#pragma unroll
  for (int r = 0; r < 16; ++r) p1[r] = __builtin_amdgcn_exp2f(p1[r]);
  float ps = 0;
#pragma unroll
  for (int r = 0; r < 16; ++r) ps += p0[r];
#pragma unroll
  for (int r = 0; r < 16; ++r) ps += p1[r];
  { auto rr = __builtin_amdgcn_permlane32_swap(__float_as_uint(ps), __float_as_uint(ps), false, false);
    ps = __uint_as_float(rr[0]) + __uint_as_float(rr[1]); }
  l_reg = l_reg * alpha + ps;
#define PK4(P, BASE, OUT) do { unsigned a0 = cvtpk(P[BASE + 0], P[BASE + 1]), a1 = cvtpk(P[BASE + 2], P[BASE + 3]);   \
    unsigned b0 = cvtpk(P[BASE + 4], P[BASE + 5]), b1 = cvtpk(P[BASE + 6], P[BASE + 7]);                              \
    auto r0 = __builtin_amdgcn_permlane32_swap(a0, b0, false, false); auto r1 = __builtin_amdgcn_permlane32_swap(a1, b1, false, false); \
    u32x4 w = {r0[0], r1[0], r0[1], r1[1]}; OUT = *reinterpret_cast<bf16x8*>(&w); } while (0)
  PK4(p0, 0, pa0); PK4(p0, 8, pa1); PK4(p1, 0, pa2); PK4(p1, 8, pa3);
#undef PK4
}
__device__ __forceinline__ void bias_init(f32x16& p0, f32x16& p1, int d, int qin, int hi, const float* tb) {
  if (d < 0 || d > 8) {
#pragma unroll
    for (int r = 0; r < 16; ++r) { p0[r] = -INFINITY; p1[r] = -INFINITY; } }
  else if (d >= 3) { const float c = tb[256];
#pragma unroll
    for (int r = 0; r < 16; ++r) { p0[r] = c; p1[r] = c; } }
  else { const float* tp = tb + (64 * d + qin + 128 - 4 * hi - 95);
#pragma unroll
    for (int r = 0; r < 16; ++r) { const int kv = (r & 3) + 8 * (r >> 2); p0[r] = tp[95 - kv]; p1[r] = tp[95 - kv - 32]; } }
}
__device__ __forceinline__ void qkt(f32x16& p0, f32x16& p1, const char* Ks, const bf16x8* qr, int r32, int hi) {
#pragma unroll
  for (int d0 = 0; d0 < 8; ++d0) { int cb = (d0 * 16 + hi * 8) * 2;
    bf16x8 b0 = *reinterpret_cast<const bf16x8*>(Ks + KSWZ(r32, cb));
    bf16x8 b1 = *reinterpret_cast<const bf16x8*>(Ks + KSWZ(32 + r32, cb));
    p0 = __builtin_amdgcn_mfma_f32_32x32x16_bf16(b0, qr[d0], p0, 0, 0, 0);
    p1 = __builtin_amdgcn_mfma_f32_32x32x16_bf16(b1, qr[d0], p1, 0, 0, 0); }
}
__device__ __forceinline__ int v_st(int k, int c) { const int kk = (k & ~0xC) | ((k & 4) << 1) | ((k & 8) >> 1); return ((kk >> 3) * 4 + (c >> 5)) * 512 + ((kk & 7) * 32 + (c & 31)) * 2; }
__device__ __forceinline__ int v_rd_base(int lane) { return ((lane & 3) << 3) | (((lane >> 2) & 3) << 6) | (((lane >> 4) & 1) << 5) | (((lane >> 5) & 1) << 8); }
constexpr int v_rd_off(int d0, int ks, int half) { return d0 * 512 + ks * 4096 + half * 2048; }
template <int OFF> __device__ __forceinline__ s16x4 tr_read(int vb) {
  s16x4 r; asm volatile("ds_read_b64_tr_b16 %0, %1 offset:%2" : "=&v"(r) : "v"(vb), "i"(OFF) : "memory"); return r;
}
template <int D0> __device__ __forceinline__ void pv_one(f32x16& od, int vb, bf16x8 pa0, bf16x8 pa1, bf16x8 pa2, bf16x8 pa3) {
  const s16x4 l0 = tr_read<v_rd_off(D0, 0, 0)>(vb), h0 = tr_read<v_rd_off(D0, 0, 1)>(vb), l1 = tr_read<v_rd_off(D0, 1, 0)>(vb), h1 = tr_read<v_rd_off(D0, 1, 1)>(vb);
  const s16x4 l2 = tr_read<v_rd_off(D0, 2, 0)>(vb), h2 = tr_read<v_rd_off(D0, 2, 1)>(vb), l3 = tr_read<v_rd_off(D0, 3, 0)>(vb), h3 = tr_read<v_rd_off(D0, 3, 1)>(vb);
  asm volatile("s_waitcnt lgkmcnt(0)" ::: "memory"); SBAR();
#define PK(L, H) (bf16x8){L[0], L[1], L[2], L[3], H[0], H[1], H[2], H[3]}
  od = __builtin_amdgcn_mfma_f32_32x32x16_bf16(pa0, PK(l0, h0), od, 0, 0, 0);
  od = __builtin_amdgcn_mfma_f32_32x32x16_bf16(pa1, PK(l1, h1), od, 0, 0, 0);
  od = __builtin_amdgcn_mfma_f32_32x32x16_bf16(pa2, PK(l2, h2), od, 0, 0, 0);
  od = __builtin_amdgcn_mfma_f32_32x32x16_bf16(pa3, PK(l3, h3), od, 0, 0, 0);
#undef PK
}
__device__ __forceinline__ void pv_d0(f32x16* o, int vb, bf16x8 pa0, bf16x8 pa1, bf16x8 pa2, bf16x8 pa3) {
  pv_one<0>(o[0], vb, pa0, pa1, pa2, pa3); pv_one<1>(o[1], vb, pa0, pa1, pa2, pa3); pv_one<2>(o[2], vb, pa0, pa1, pa2, pa3); pv_one<3>(o[3], vb, pa0, pa1, pa2, pa3);
}

struct AUnit {
  const bf16* wsb;
  const bf16* q;
  long kA, vA;
  long kB, vB;
  int tsw, t0, nt, nwq;
};
__device__ __forceinline__ void attn_unit(const AUnit& u, char* lds, f32x16 (&o)[4], float (&rli)[16]) {
  const int tid = threadIdx.x, wid = __builtin_amdgcn_readfirstlane(tid >> 6), lane = tid & 63, r32 = lane & 31, hi = lane >> 5;
  char* V_lds = lds + L_V; char* K_lds = lds + L_K;
  float* wsf = (float*)(lds + L_WS) + wid * 64; float* li_l = wsf; float* al_l = wsf + 32;
  const float* tb = (const float*)(lds + L_TB);
  float m_reg = -1e30f, l_reg = 0; bf16x8 qr[8];
#pragma unroll
  for (int d = 0; d < 4; ++d) o[d] = f32x16{};
  const bool wq = wid < u.nwq;
  const int wrow = wq ? wid * QBLK : (wid & 1) * QBLK;
  const bf16* Qw = u.q + (long)(wrow + r32) * 1024 + hi * 8;
#pragma unroll
  for (int d0 = 0; d0 < 8; ++d0) qr[d0] = *reinterpret_cast<const bf16x8*>(Qw + d0 * 16);
  const int sr = tid >> 4, sc = (tid & 15) * 8, vst0 = v_st(sr, sc), vst1 = v_st(32 + sr, sc);
  const int vb0 = (int)(uintptr_t)V_lds + v_rd_base(lane);
  const int qin = (wid & 1) * QBLK + r32, wch = wid >> 1;
  struct { bf16x8 vs0, vs1, ks0, ks1; } sr_[2];
#define TOFF(t, A, B) (((t) < u.tsw) ? (A) + (long)(t) * TILE_ELEMS : (B))
#define SLOAD(i, t) do { const bf16* kp_ = u.wsb + TOFF(t, u.kA, u.kB) + (long)sr * 1024 + sc; const bf16* vp_ = u.wsb + TOFF(t, u.vA, u.vB) + (long)sr * 1024 + sc; \
    sr_[i].vs0 = *reinterpret_cast<const bf16x8*>(vp_); sr_[i].vs1 = *reinterpret_cast<const bf16x8*>(vp_ + 32 * 1024); \
    sr_[i].ks0 = *reinterpret_cast<const bf16x8*>(kp_); sr_[i].ks1 = *reinterpret_cast<const bf16x8*>(kp_ + 32 * 1024); } while (0)
#define SWRITE(b, i) do { *(bf16x8*)(V_lds + (b) * SHM_V + vst0) = sr_[i].vs0; *(bf16x8*)(V_lds + (b) * SHM_V + vst1) = sr_[i].vs1; int kc = sc * 2; \
    *(bf16x8*)(K_lds + (b) * SHM_K + KSWZ(sr, kc)) = sr_[i].ks0; *(bf16x8*)(K_lds + (b) * SHM_K + KSWZ(32 + sr, kc)) = sr_[i].ks1; } while (0)
#define SWAIT() asm volatile("s_waitcnt vmcnt(4)" ::: "memory")
#define RESC(a) do { if (__any((a) < 1.f)) { if (hi == 0) al_l[r32] = (a); asm volatile("s_waitcnt lgkmcnt(0)" ::: "memory"); \
    _Pragma("unroll") for (int d = 0; d < 4; ++d) _Pragma("unroll") for (int r = 0; r < 16; ++r) o[d][r] *= al_l[crow(r, hi)]; } } while (0)
#define DIST(t) (wq ? (wch + 8 - (t)) : -1)
  f32x16 pA0, pA1, pB0, pB1; float mnA, mnB, alA, alB; bf16x8 pa0, pa1, pa2, pa3; const int NT = u.nt, T0 = u.t0;
  constexpr int SE = 0, SO = 1;
  SLOAD(SE, T0); asm volatile("s_waitcnt vmcnt(0)" ::: "memory"); SWRITE(0, SE); __syncthreads();
  bias_init(pA0, pA1, DIST(T0), qin, hi, tb); qkt(pA0, pA1, K_lds, qr, r32, hi); partialSM(pA0, pA1, m_reg, mnA, alA);
  SLOAD(SO, T0 + 1); SLOAD(SE, T0 + 2);
  SWAIT(); SWRITE(1, SO); __syncthreads();
  for (int j = T0 + 1; j + 1 < NT; j += 2) {
    SBAR(); bias_init(pB0, pB1, DIST(j), qin, hi, tb); qkt(pB0, pB1, K_lds + SHM_K, qr, r32, hi);
    finishSM(pA0, pA1, alA, l_reg, pa0, pa1, pa2, pa3); SBAR();
    SLOAD(SO, j + 2); SBAR();
    pv_d0(o, vb0, pa0, pa1, pa2, pa3); partialSM(pB0, pB1, m_reg, mnB, alB);
    __syncthreads(); SWAIT(); SWRITE(0, SE);
    RESC(alB); __syncthreads();
    SBAR(); bias_init(pA0, pA1, DIST(j + 1), qin, hi, tb); qkt(pA0, pA1, K_lds, qr, r32, hi);
    finishSM(pB0, pB1, alB, l_reg, pa0, pa1, pa2, pa3); SBAR();
    if (j + 3 < NT) SLOAD(SE, j + 3); SBAR();
    pv_d0(o, vb0 + SHM_V, pa0, pa1, pa2, pa3); partialSM(pA0, pA1, m_reg, mnA, alA);
    __syncthreads(); SWAIT(); SWRITE(1, SO);
    RESC(alA); __syncthreads();
  }
  SBAR(); bias_init(pB0, pB1, DIST(NT - 1), qin, hi, tb); qkt(pB0, pB1, K_lds + SHM_K, qr, r32, hi);
  finishSM(pA0, pA1, alA, l_reg, pa0, pa1, pa2, pa3); SBAR();
  pv_d0(o, vb0, pa0, pa1, pa2, pa3); partialSM(pB0, pB1, m_reg, mnB, alB);
  RESC(alB);
  finishSM(pB0, pB1, alB, l_reg, pa0, pa1, pa2, pa3); SBAR();
  pv_d0(o, vb0 + SHM_V, pa0, pa1, pa2, pa3);
#undef DIST
  if (hi == 0) li_l[r32] = l_reg; asm volatile("s_waitcnt lgkmcnt(0)" ::: "memory");
#pragma unroll
  for (int r = 0; r < 16; ++r) rli[r] = __builtin_amdgcn_rcpf(li_l[crow(r, hi)]);
  __syncthreads();
#undef TOFF
#undef SLOAD
#undef SWRITE
#undef SWAIT
#undef RESC
}
#undef SBAR
}

#define GAS __attribute__((address_space(1)))
#define LAS __attribute__((address_space(3)))
typedef unsigned short bf16;
typedef unsigned v4u __attribute__((ext_vector_type(4)));
typedef float f32x4 __attribute__((ext_vector_type(4)));
typedef short bf16x8 __attribute__((ext_vector_type(8)));
typedef GAS unsigned gu32;
typedef GAS unsigned long long gu64;
#define RLX_AGENT __ATOMIC_RELAXED, __HIP_MEMORY_SCOPE_AGENT
#define LDS_WAIT() asm volatile("s_waitcnt lgkmcnt(0)" ::: "memory")
#define VM_WAIT() asm volatile("s_waitcnt vmcnt(0)" ::: "memory")
__device__ __forceinline__ unsigned long long rt() { return __builtin_amdgcn_s_memrealtime(); }
__device__ __forceinline__ unsigned f2bf(float f) { unsigned u = __builtin_bit_cast(unsigned, f); return (u + 0x7fffu + ((u >> 16) & 1u)) >> 16; }
__device__ __forceinline__ unsigned pk2(float lo, float hi) { return f2bf(lo) | (f2bf(hi) << 16); }

#define XB_TMO      128
#define XB_XCNT(j)  (256  + 64 * (j))
#define XB_XSUB(j)  (1280 + 64 * (j))
#define XB_XGEN(j)  (2304 + 64 * (j))
#define XB_TOP      3328
#define XB_TOPGEN   3392
#define XCD_BAR_WORDS 3456
#define XB_SPIN_CAP (1u << 18)

__device__ __forceinline__ unsigned xb_ld(unsigned* p)              { return __hip_atomic_load(p, __ATOMIC_RELAXED, __HIP_MEMORY_SCOPE_AGENT); }
__device__ __forceinline__ unsigned xb_add(unsigned* p, unsigned v) { return __hip_atomic_fetch_add(p, v, __ATOMIC_RELAXED, __HIP_MEMORY_SCOPE_AGENT); }
__device__ __forceinline__ unsigned xb_xcc_id() { return (unsigned)__builtin_amdgcn_s_getreg((3 << 11) | 20) & 0xFu; }
#define XB_SPIN(cond, bar) do { unsigned _sp = 0; while (cond) { __builtin_amdgcn_s_sleep(1); \
    if ((++_sp & 255u) == 0u) { if (xb_ld(&(bar)[XB_TMO])) break; if (_sp > XB_SPIN_CAP) { atomicAdd(&(bar)[XB_TMO], 1u); break; } } } } while (0)

struct XcdBarrier {
    unsigned* bar; unsigned x;
    volatile LAS unsigned* st;
};

__device__ __forceinline__ XcdBarrier xcd_barrier_post(unsigned* bar, volatile LAS unsigned* st) {
    XcdBarrier b; b.bar = bar; b.x = xb_xcc_id(); b.st = st;
    if (threadIdx.x == 0) (void)xb_add(&bar[XB_XCNT(b.x)], 1u);
    return b;
}
__device__ __forceinline__ void xcd_barrier_complete(unsigned* bar, unsigned x, unsigned& nloc, unsigned& nx) {
    const unsigned G = gridDim.x * gridDim.y * gridDim.z;
    unsigned sum, cnt, mine, sp = 0u;
    for (;;) {
        sum = 0u; cnt = 0u; mine = 0u;
#pragma unroll
        for (unsigned j = 0; j < 16; ++j) { const unsigned c = xb_ld(&bar[XB_XCNT(j)]); sum += c; cnt += (c > 0u) ? 1u : 0u; mine = (j == x) ? c : mine; }
        if (sum == G) break;
        __builtin_amdgcn_s_sleep(1);
        if ((++sp & 255u) == 0u) { if (xb_ld(&bar[XB_TMO])) break; if (sp > XB_SPIN_CAP) { atomicAdd(&bar[XB_TMO], 1u); break; } }
    }
    nloc = mine > 0u ? mine : 1u; nx = cnt > 0u ? cnt : 1u;
}

__device__ __forceinline__ void xcd_barrier(const XcdBarrier& b) {
    asm volatile("s_waitcnt vmcnt(0)" ::: "memory");
    __syncthreads();
    if (threadIdx.x == 0) {
        unsigned* bar = b.bar;
        __builtin_amdgcn_s_waitcnt(0);
        unsigned nloc = b.st[0], nx = b.st[1];
        if (nloc == 0u) { xcd_barrier_complete(bar, b.x, nloc, nx); b.st[0] = nloc; b.st[1] = nx; }
        const unsigned old = xb_add(&bar[XB_XSUB(b.x)], 1u);
        const unsigned gen = old / nloc;
        if (old + 1u == (gen + 1u) * nloc) {
            __builtin_amdgcn_fence(__ATOMIC_RELEASE, "agent");
            asm volatile("s_waitcnt vmcnt(0)" ::: "memory");
            const unsigned og = xb_add(&bar[XB_TOP], 1u);
            const unsigned tg = og / nx;
            if (og + 1u == (tg + 1u) * nx) xb_add(&bar[XB_TOPGEN], 1u);
            else XB_SPIN(xb_ld(&bar[XB_TOPGEN]) == tg, bar);
            __builtin_amdgcn_fence(__ATOMIC_ACQUIRE, "agent");
            xb_add(&bar[XB_XGEN(b.x)], 1u);
            asm volatile("s_waitcnt vmcnt(0)" ::: "memory");
        } else {
            XB_SPIN(xb_ld(&bar[XB_XGEN(b.x)]) == gen, bar);
            __builtin_amdgcn_fence(__ATOMIC_ACQUIRE, "agent");
            asm volatile("s_waitcnt vmcnt(0)" ::: "memory");
        }
    }
    __syncthreads();
}


constexpr int NWAVES = 8;
#ifndef MK_N_LAUNCHES
#define MK_N_LAUNCHES 1
#endif
constexpr int N_PHASES = 10;
constexpr int N_LAUNCHES = MK_N_LAUNCHES;
static_assert(N_LAUNCHES == 1 || N_LAUNCHES == N_PHASES, "MK_N_LAUNCHES is 1 or 10");
#ifndef MK_REPEAT_PHASE
#define MK_REPEAT_PHASE (-1)
#endif

constexpr int DM = 1024, BP = 8, TP = 8192, BS = 8, TSQ = 64, MP = BP * TP, MS = BS * TSQ, M = MP + MS;
constexpr int DIN = 7168, FF = 4096, NH = 8, HD = 128, CROWS = 512, NCHUNK = TP / 64;
constexpr float LN_EPS = 1e-5f, ALPHA = 1.189207115002721f;
static_assert(M % 256 == 0, "row tiles");
enum { ZXR = 0, ZGL = 1, ZQ = 2, ZK = 3, ZV = 4, ZGA = 5, ZGB = 6 };
constexpr int MOD_SH1 = 0, MOD_SC1 = 1024, MOD_G1 = 2048, MOD_SH2 = 3072, MOD_SC2 = 4096, MOD_G2 = 5120;

constexpr size_t MiB = 1u << 20;
constexpr size_t WS_CTL = 0, CTL_ZERO_BYTES = 1 * MiB;
constexpr size_t WS_MOD = 1 * MiB;
constexpr size_t WS_WIN = 2 * MiB, WS_WOUT = 16 * MiB, WS_WUP = 18 * MiB, WS_WDN = 26 * MiB, WS_WRG = 34 * MiB, WS_WIG = 34 * MiB + 256 * 1024;
constexpr size_t WS_CK = 35 * MiB, WS_CV = 43 * MiB;
constexpr size_t WS_AGG = 51 * MiB;
constexpr size_t WS_Z = 64 * MiB, ZBUF = (size_t)M * 1024 * 2;
constexpr size_t WS_END = WS_Z + 7 * ZBUF;
constexpr size_t WS_MERGED = WS_Z, WS_U2 = WS_Z, WS_X1 = WS_Z + ZBUF, WS_H = WS_Z + 3 * ZBUF;
constexpr size_t OUT_YP = 0, OUT_YS = 67108864, OUT_KP = 67633152, OUT_VP = 71827456, OUT_CP = 76021760, OUT_HP = 76046336, OUT_KS = 76054528, OUT_VS = 76578816, OUT_CS = 77103104, OUT_HS = 77127680, OUT_TOTAL = 77135872;
constexpr int CW_TMO = 0, CW_CODE = 1, CW_BAR = 4096;

constexpr int RING_OFF = 0, RING_BYTES = 131072;
constexpr int SCRATCH_BYTES = 155648;
constexpr int LDSCTL_OFF = SCRATCH_BYTES, MISC_OFF = LDSCTL_OFF + 320;
constexpr int LDS_BYTES = 163840;
static_assert(MISC_OFF + 128 <= LDS_BYTES, "LDS map");
constexpr int LW_RG = 0, LW_IG = 32768, L_XR = 65536, L_XC = 82944, L_G = 99328, L_Y1 = 115712, L_AGG = 132096, L_CAR = 136192;
static_assert(L_CAR + 1024 <= SCRATCH_BYTES && attn::ATTN_LDS <= SCRATCH_BYTES, "LDS scratch");


struct Frame {
    LAS unsigned char* lds;
    volatile LAS unsigned* MISC;
    gu32* ctl;
    int tid, lane, wave;
    int vcu, G;
    const float *x_p, *x_s, *c_p, *c_s, *cache_k, *cache_v, *state_conv, *state_lru, *w_ada, *b_ada, *w_in, *conv_w, *conv_b, *w_rg, *b_rg, *w_ig, *b_ig, *lam, *rel_bias,
                *w_out, *ln1_g, *ln1_b, *w_up, *b_up, *w_down, *b_down, *ln2_g, *ln2_b;
    float* out; unsigned char* ws;
    float* mod; float* agg;
    bf16 *Win_t, *Wout_t, *Wup_t, *Wdn_t, *Wrg_t, *Wig_t, *CK, *CV, *Z;
};
__device__ __forceinline__ bf16* zbuf(Frame& F, int i) { return (bf16*)(F.ws + WS_Z + (size_t)i * ZBUF); }
__device__ __forceinline__ float sigmoid_f(float x) { return __builtin_amdgcn_rcpf(1.f + __builtin_amdgcn_exp2f(-1.4426950408889634f * x)); }
__device__ __forceinline__ float gelu_tanh_f(float x) { const float y = 0.7978845608028654f * (x + 0.044715f * x * x * x); return x * sigmoid_f(2.f * y); }
__device__ __forceinline__ float bf2f(unsigned short v) { return __uint_as_float(((unsigned)v) << 16); }
__device__ __forceinline__ int batch_of_row(int row) { return row < MP ? (row >> 13) : 8 + ((row - MP) >> 6); }

__device__ __forceinline__ float wave_sum(float v) {
#pragma unroll
    for (int o = 1; o < 64; o <<= 1) v += __shfl_xor(v, o);
    return v;
}
__device__ __forceinline__ void p0_transpose_item(const float* W, int K, int N, bf16* WT, int row_off, LAS float* scr, int item, int lane) {
    const int nblk = N / 32, kb = item / nblk, nb = item % nblk, k0 = 64 * kb, n0 = 32 * nb;
#pragma unroll 8
    for (int i = 0; i < 32; ++i) { const int kk = 2 * i + (lane >> 5); scr[kk * 33 + (lane & 31)] = W[(size_t)(k0 + kk) * N + n0 + (lane & 31)]; }
    LDS_WAIT(); asm volatile("" ::: "memory");
    const int c = lane & 7;
#pragma unroll
    for (int j = 0; j < 4; ++j) { const int n = (lane >> 3) + 8 * j; const LAS float* s = scr + (8 * c) * 33 + n;
        v4u o; o.x = pk2(s[0 * 33], s[1 * 33]); o.y = pk2(s[2 * 33], s[3 * 33]); o.z = pk2(s[4 * 33], s[5 * 33]); o.w = pk2(s[6 * 33], s[7 * 33]);
        *(GAS v4u*)(WT + (size_t)(row_off + n0 + n) * K + k0 + 8 * c) = o; }
    LDS_WAIT(); asm volatile("" ::: "memory");
}
__device__ __forceinline__ void p0_mod_item(Frame& F, const LAS float* sl, int it) {
    const int cb = it >> 2, bq = it & 3, kq = F.lane >> 4, cq = F.lane & 15, col = 64 * cb + 4 * cq;
    f32x4 acc[4];
#pragma unroll
    for (int bb = 0; bb < 4; ++bb) acc[bb] = (f32x4){0.f, 0.f, 0.f, 0.f};
    const float* wp = F.w_ada + (size_t)(256 * kq) * 6144 + col;
    const LAS float* sp = sl + (4 * bq) * 1024 + 256 * kq;
#pragma unroll 2
    for (int kk = 0; kk < 256; kk += 4) {
        f32x4 s[4];
#pragma unroll
        for (int bb = 0; bb < 4; ++bb) s[bb] = *(const LAS f32x4*)(sp + bb * 1024 + kk);
#pragma unroll
        for (int i = 0; i < 4; ++i) { const f32x4 w = *(const f32x4*)(wp + (size_t)(kk + i) * 6144);
#pragma unroll
            for (int bb = 0; bb < 4; ++bb) acc[bb] += w * s[bb][i]; }
    }
#pragma unroll
    for (int bb = 0; bb < 4; ++bb)
#pragma unroll
        for (int e = 0; e < 4; ++e) { float v = acc[bb][e]; v += __shfl_xor(v, 16); v += __shfl_xor(v, 32); acc[bb][e] = v; }
    if (kq == 0) { const f32x4 bv = *(const f32x4*)(F.b_ada + col);
#pragma unroll
        for (int bb = 0; bb < 4; ++bb) *(f32x4*)(F.mod + (size_t)(4 * bq + bb) * 6144 + col) = acc[bb] + bv; }
}
__device__ __forceinline__ void p0_prologue(Frame& F) {
    LAS float* sl = (LAS float*)F.lds;
    for (int i = F.tid; i < 16 * 1024; i += NWAVES * 64) { const float c = i < 8192 ? F.c_p[i] : F.c_s[i - 8192]; sl[i] = c / (1.f + __expf(-c)); }
    __syncthreads();
    LAS float* scr = (LAS float*)(F.lds + 65536 + F.wave * 8448);
    const int gw = F.vcu * NWAVES + F.wave, NGW = F.G * NWAVES;
    constexpr int I_MOD = 384, I_IN = (DM / 64) * (DIN / 32), I_OUT = (DM / 64) * (DM / 32), I_UP = (DM / 64) * (FF / 32), I_DN = (FF / 64) * (DM / 32), I_G = 8 * 8;
    constexpr int NITEMS = I_MOD + I_IN + I_OUT + I_UP + I_DN + 2 * I_G;
    for (int it = gw; it < NITEMS; it += NGW) {
        int r = it;
        if (r < I_MOD) { p0_mod_item(F, sl, r); continue; } r -= I_MOD;
        if (r < I_IN) { p0_transpose_item(F.w_in, DM, DIN, F.Win_t, 0, scr, r, F.lane); continue; } r -= I_IN;
        if (r < I_OUT) { p0_transpose_item(F.w_out, DM, DM, F.Wout_t, 0, scr, r, F.lane); continue; } r -= I_OUT;
        if (r < I_UP) { p0_transpose_item(F.w_up, DM, FF, F.Wup_t, 0, scr, r, F.lane); continue; } r -= I_UP;
        if (r < I_DN) { p0_transpose_item(F.w_down, FF, DM, F.Wdn_t, 0, scr, r, F.lane); continue; } r -= I_DN;
        if (r < I_G) { const int n = r >> 3; p0_transpose_item(F.w_rg + (size_t)n * 16384, 128, 128, F.Wrg_t + (size_t)n * 16384, 0, scr, r & 7, F.lane); continue; } r -= I_G;
        { const int n = r >> 3; p0_transpose_item(F.w_ig + (size_t)n * 16384, 128, 128, F.Wig_t + (size_t)n * 16384, 0, scr, r & 7, F.lane); }
    }
    constexpr int NC8 = 4194304 / 8;
    for (int i = gw * 64 + F.lane; i < 2 * NC8; i += NGW * 64) {
        const bool isk = i < NC8; const int j = isk ? i : i - NC8;
        const float* src = (isk ? F.cache_k : F.cache_v) + (size_t)j * 8;
        const f32x4 a = *(const f32x4*)src, b = *(const f32x4*)(src + 4);
        v4u o; o.x = pk2(a.x, a.y); o.y = pk2(a.z, a.w); o.z = pk2(b.x, b.y); o.w = pk2(b.z, b.w);
        *(GAS v4u*)((isk ? F.CK : F.CV) + (size_t)j * 8) = o;
    }
}
__device__ __forceinline__ void p1_upass(Frame& F, bf16* U) {
    const int gw = F.vcu * NWAVES + F.wave, NGW = F.G * NWAVES;
    for (int m = gw; m < M; m += NGW) {
        const float* xr = m < MP ? F.x_p + (size_t)m * 1024 : F.x_s + (size_t)(m - MP) * 1024;
        const float* md = F.mod + (size_t)batch_of_row(m) * 6144;
        GAS unsigned long long* o8 = (GAS unsigned long long*)(U + (size_t)m * 1024) + F.lane;
#pragma unroll
        for (int j = 0; j < 4; ++j) { const int idx = 4 * F.lane + 256 * j;
            const f32x4 x = *(const f32x4*)(xr + idx), sh = *(const f32x4*)(md + MOD_SH1 + idx), sc = *(const f32x4*)(md + MOD_SC1 + idx);
            const f32x4 u = x * (sc + 1.0f) + sh;
            o8[64 * j] = (unsigned long long)pk2(u.x, u.y) | ((unsigned long long)pk2(u.z, u.w) << 32); }
    }
}
template <bool FIRST> __device__ __forceinline__ void ln_pass(Frame& F, const float* R, float* X1, bf16* U2, const float* g, const float* bta) {
    const int gw = F.vcu * NWAVES + F.wave, NGW = F.G * NWAVES;
    for (int m = gw; m < M; m += NGW) {
        const float* rr = R + (size_t)m * 1024;
        f32x4 v[4]; float s = 0.f;
#pragma unroll
        for (int j = 0; j < 4; ++j) { v[j] = *(const f32x4*)(rr + 4 * F.lane + 256 * j); s += (v[j].x + v[j].y) + (v[j].z + v[j].w); }
        const float mean = wave_sum(s) * (1.f / 1024.f); float s2 = 0.f;
#pragma unroll
        for (int j = 0; j < 4; ++j) { v[j] = v[j] - mean; s2 += (v[j].x * v[j].x + v[j].y * v[j].y) + (v[j].z * v[j].z + v[j].w * v[j].w); }
        const float rstd = 1.f / sqrtf(wave_sum(s2) * (1.f / 1024.f) + LN_EPS);
        const float* md = F.mod + (size_t)batch_of_row(m) * 6144;
#pragma unroll
        for (int j = 0; j < 4; ++j) { const int idx = 4 * F.lane + 256 * j;
            const f32x4 y = v[j] * rstd * *(const f32x4*)(g + idx) + *(const f32x4*)(bta + idx);
            *(f32x4*)(X1 + (size_t)m * 1024 + idx) = y;
            if (FIRST) { const f32x4 sh = *(const f32x4*)(md + MOD_SH2 + idx), sc = *(const f32x4*)(md + MOD_SC2 + idx); const f32x4 u = y * (sc + 1.0f) + sh;
                *((GAS unsigned long long*)(U2 + (size_t)m * 1024 + idx)) = (unsigned long long)pk2(u.x, u.y) | ((unsigned long long)pk2(u.z, u.w) << 32); } }
    }
}
#define LSWZ(row, colB) ((row) * 256 + ((colB) ^ (((row) & 7) << 4)))
__device__ __forceinline__ v4u g_tile8(const v4u gl, const v4u ga) {
    float g[8];
    const unsigned lw[4] = {gl.x, gl.y, gl.z, gl.w}, aw[4] = {ga.x, ga.y, ga.z, ga.w};
#pragma unroll
    for (int e = 0; e < 4; ++e) { g[2 * e] = gelu_tanh_f(__uint_as_float(lw[e] << 16)) * sigmoid_f(__uint_as_float(aw[e] << 16));
        g[2 * e + 1] = gelu_tanh_f(__uint_as_float(lw[e] & 0xffff0000u)) * sigmoid_f(__uint_as_float(aw[e] & 0xffff0000u)); }
    v4u o; o.x = pk2(g[0], g[1]); o.y = pk2(g[2], g[3]); o.z = pk2(g[4], g[5]); o.w = pk2(g[6], g[7]); return o;
}
__device__ __forceinline__ void p3_lru(Frame& F, bf16* Y0, bf16* Y1) {
    LAS unsigned char* L = F.lds;
    const int pair = F.vcu >> 2, quarter = F.vcu & 3, b = pair >> 3, n = pair & 7;
    const bf16* XR = zbuf(F, ZXR); const bf16* GL = zbuf(F, ZGL); const bf16* GA = zbuf(F, ZGA);
    for (int idx = F.tid; idx < 2 * 2048; idx += NWAVES * 64) { const int g = idx >> 11, r = (idx >> 4) & 127, ch = idx & 15;
        const bf16* src = (g ? F.Wig_t : F.Wrg_t) + ((size_t)(n * 128 + r)) * 128 + ch * 8;
        *(LAS v4u*)(L + (g ? LW_IG : LW_RG) + LSWZ(r, ch * 16)) = *(const v4u*)src; }
    const int w = F.wave, rb = w & 3, chf = w >> 2, fr = F.lane & 15, fq = F.lane >> 4;
    const int st = F.tid >> 3, scg = F.tid & 7, scl = scg * 16, sch = n * 128 + scl;
    float brg[4], big[4], c8[4];
#pragma unroll
    for (int cb = 0; cb < 4; ++cb) { const int dch = n * 128 + 64 * chf + 16 * cb + fr; brg[cb] = F.b_rg[dch]; big[cb] = F.b_ig[dch]; c8[cb] = -8.0f * log1pf(__expf(-F.lam[dch])) * 1.4426950408889634f; }
    LAS float* carry = (LAS float*)(L + L_CAR);
    LAS float* aggl = (LAS float*)(L + L_AGG);
    if (F.tid < 128) { carry[2 * F.tid] = 1.f; carry[2 * F.tid + 1] = 0.f; }
    const int nitems = 32 + (quarter == 0 ? 1 : 0);
    v4u xr0, xr1, gl0, gl1, ga0, ga1, xp0, xp1;
#define ITEM_ROW0(it) ((it) < 32 ? (size_t)b * TP + (size_t)(32 * quarter + (it)) * 64 : (size_t)MP + (size_t)b * 64)
#define STAGE_LOAD(it) do { const size_t gi_ = (ITEM_ROW0(it) + st) * 1024 + sch; xr0 = *(const v4u*)(XR + gi_); xr1 = *(const v4u*)(XR + gi_ + 8); \
        gl0 = *(const v4u*)(GL + gi_); gl1 = *(const v4u*)(GL + gi_ + 8); ga0 = *(const v4u*)(GA + gi_); ga1 = *(const v4u*)(GA + gi_ + 8); } while (0)
#define STAGE_WRITE(it) do { \
        *(LAS v4u*)(L + L_XR + LSWZ(3 + st, scl * 2)) = xr0; *(LAS v4u*)(L + L_XR + LSWZ(3 + st, scl * 2 + 16)) = xr1; \
        *(LAS v4u*)(L + L_G + st * 256 + scl * 2) = g_tile8(gl0, ga0); *(LAS v4u*)(L + L_G + st * 256 + scl * 2 + 16) = g_tile8(gl1, ga1); \
        if (st >= 61) { v4u h0_, h1_; \
            if ((it) == 32) { const float* sp_ = F.state_conv + ((size_t)b * 3 + (st - 61)) * 1024 + sch; const f32x4 a_ = *(const f32x4*)sp_, b_ = *(const f32x4*)(sp_ + 4), c_ = *(const f32x4*)(sp_ + 8), d_ = *(const f32x4*)(sp_ + 12); \
                h0_.x = pk2(a_.x, a_.y); h0_.y = pk2(a_.z, a_.w); h0_.z = pk2(b_.x, b_.y); h0_.w = pk2(b_.z, b_.w); h1_.x = pk2(c_.x, c_.y); h1_.y = pk2(c_.z, c_.w); h1_.z = pk2(d_.x, d_.y); h1_.w = pk2(d_.z, d_.w); } \
            else if ((it) > 0) { h0_ = xp0; h1_ = xp1; } \
            else if (quarter == 0) { h0_ = (v4u){0u, 0u, 0u, 0u}; h1_ = h0_; } \
            else { const size_t gp_ = (ITEM_ROW0(0) - 64 + st) * 1024 + sch; h0_ = *(const v4u*)(XR + gp_); h1_ = *(const v4u*)(XR + gp_ + 8); } \
            *(LAS v4u*)(L + L_XR + LSWZ(st - 61, scl * 2)) = h0_; *(LAS v4u*)(L + L_XR + LSWZ(st - 61, scl * 2 + 16)) = h1_; \
            if ((it) == 32 || (quarter == 3 && (it) == 31)) { float* oc_ = F.out + ((it) == 32 ? OUT_CS : OUT_CP) + ((size_t)b * 3 + (st - 61)) * 1024 + sch; \
                const unsigned xw_[8] = {xr0.x, xr0.y, xr0.z, xr0.w, xr1.x, xr1.y, xr1.z, xr1.w}; \
                _Pragma("unroll") for (int e_ = 0; e_ < 4; ++e_) *(f32x4*)(oc_ + 4 * e_) = (f32x4){__uint_as_float(xw_[2 * e_] << 16), __uint_as_float(xw_[2 * e_] & 0xffff0000u), __uint_as_float(xw_[2 * e_ + 1] << 16), __uint_as_float(xw_[2 * e_ + 1] & 0xffff0000u)}; } } \
        xp0 = xr0; xp1 = xr1; } while (0)
    STAGE_LOAD(0);
    STAGE_WRITE(0);
    __syncthreads();
    for (int it = 0; it < nitems; ++it) {
        const bool smp = it == 32; const size_t row0 = ITEM_ROW0(it);
        if (smp) {
            if (F.tid < 128) { float* ao = F.agg + ((size_t)(b * 8 + n) * 4 + quarter) * 256; ao[F.tid] = carry[2 * F.tid]; ao[128 + F.tid] = carry[2 * F.tid + 1];
                carry[2 * F.tid] = 1.f; carry[2 * F.tid + 1] = F.state_lru[(size_t)b * 1024 + n * 128 + F.tid]; }
            __syncthreads(); }
        if (it + 1 < nitems) STAGE_LOAD(it + 1);
#pragma unroll
        for (int half = 0; half < 2; ++half) { const int cl = scl + 8 * half, ch = n * 128 + cl;
            float xc[8];
            { const f32x4 c0 = *(const f32x4*)(F.conv_b + ch), c1 = *(const f32x4*)(F.conv_b + ch + 4); xc[0] = c0.x; xc[1] = c0.y; xc[2] = c0.z; xc[3] = c0.w; xc[4] = c1.x; xc[5] = c1.y; xc[6] = c1.z; xc[7] = c1.w; }
#pragma unroll
            for (int k = 0; k < 4; ++k) { const v4u raw = *(const LAS v4u*)(L + L_XR + LSWZ(st + k, cl * 2));
                const f32x4 w0 = *(const f32x4*)(F.conv_w + (size_t)k * 1024 + ch), w1 = *(const f32x4*)(F.conv_w + (size_t)k * 1024 + ch + 4);
                xc[0] = fmaf(__uint_as_float(raw.x << 16), w0.x, xc[0]); xc[1] = fmaf(__uint_as_float(raw.x & 0xffff0000u), w0.y, xc[1]);
                xc[2] = fmaf(__uint_as_float(raw.y << 16), w0.z, xc[2]); xc[3] = fmaf(__uint_as_float(raw.y & 0xffff0000u), w0.w, xc[3]);
                xc[4] = fmaf(__uint_as_float(raw.z << 16), w1.x, xc[4]); xc[5] = fmaf(__uint_as_float(raw.z & 0xffff0000u), w1.y, xc[5]);
                xc[6] = fmaf(__uint_as_float(raw.w << 16), w1.z, xc[6]); xc[7] = fmaf(__uint_as_float(raw.w & 0xffff0000u), w1.w, xc[7]); }
            v4u o; o.x = pk2(xc[0], xc[1]); o.y = pk2(xc[2], xc[3]); o.z = pk2(xc[4], xc[5]); o.w = pk2(xc[6], xc[7]);
            *(LAS v4u*)(L + L_XC + LSWZ(st, cl * 2)) = o; }
        __syncthreads();
        float Pl[4][4], hl[4][4], ep[4], eh[4];
        { f32x4 acc[2][4];
#pragma unroll
          for (int g = 0; g < 2; ++g)
#pragma unroll
            for (int cb = 0; cb < 4; ++cb) acc[g][cb] = (f32x4){0.f, 0.f, 0.f, 0.f};
#pragma unroll
          for (int ks = 0; ks < 4; ++ks) { const int kb = (32 * ks + 8 * fq) * 2;
            const bf16x8 A = *(const LAS bf16x8*)(L + L_XC + LSWZ(16 * rb + fr, kb));
#pragma unroll
            for (int cb = 0; cb < 4; ++cb) { const int d = 64 * chf + 16 * cb + fr;
                const bf16x8 Br = *(const LAS bf16x8*)(L + LW_RG + LSWZ(d, kb)), Bi = *(const LAS bf16x8*)(L + LW_IG + LSWZ(d, kb));
                acc[0][cb] = __builtin_amdgcn_mfma_f32_16x16x32_bf16(A, Br, acc[0][cb], 0, 0, 0);
                acc[1][cb] = __builtin_amdgcn_mfma_f32_16x16x32_bf16(A, Bi, acc[1][cb], 0, 0, 0); } }
          const bool reset = (quarter == 0 && it == 0 && rb == 0 && fq == 0);
#pragma unroll
          for (int cb = 0; cb < 4; ++cb) { const int dl = 64 * chf + 16 * cb + fr;
            float P = 1.f, h = 0.f;
#pragma unroll
            for (int rg = 0; rg < 4; ++rg) { const int t = 16 * rb + 4 * fq + rg;
                const float r = sigmoid_f(acc[0][cb][rg] + brg[cb]), ig = sigmoid_f(acc[1][cb][rg] + big[cb]);
                float a = __builtin_amdgcn_exp2f(c8[cb] * r); float mult = __builtin_amdgcn_sqrtf(fmaxf(1.f - a * a, 0.f));
                if (reset && rg == 0) { a = 0.f; mult = 1.f; }
                const float xcv = bf2f(*(const LAS unsigned short*)(L + L_XC + LSWZ(t, dl * 2)));
                h = fmaf(a, h, mult * ig * xcv); P = a * P; Pl[cb][rg] = P; hl[cb][rg] = h; }
            float Pg = P, Hg = h;
            { const float up = __shfl_up(Pg, 16), uh = __shfl_up(Hg, 16); if (fq >= 1) { Hg = fmaf(Pg, uh, Hg); Pg = Pg * up; } }
            { const float up = __shfl_up(Pg, 32), uh = __shfl_up(Hg, 32); if (fq >= 2) { Hg = fmaf(Pg, uh, Hg); Pg = Pg * up; } }
            { const float up = __shfl_up(Pg, 16), uh = __shfl_up(Hg, 16); ep[cb] = fq == 0 ? 1.f : up; eh[cb] = fq == 0 ? 0.f : uh; }
            if (fq == 3) { aggl[(rb * 128 + dl) * 2] = Pg; aggl[(rb * 128 + dl) * 2 + 1] = Hg; } }
        }
        __syncthreads();
        float ncP[4], nch[4];
#pragma unroll
        for (int cb = 0; cb < 4; ++cb) { const int dl = 64 * chf + 16 * cb + fr;
            float Pin = carry[2 * dl], Hin = carry[2 * dl + 1];
            for (int q2 = 0; q2 < rb; ++q2) { const float Pq = aggl[(q2 * 128 + dl) * 2], Hq = aggl[(q2 * 128 + dl) * 2 + 1]; Hin = fmaf(Pq, Hin, Hq); Pin = Pq * Pin; }
            const float Hs = fmaf(ep[cb], Hin, eh[cb]), Ps = ep[cb] * Pin;
#pragma unroll
            for (int rg = 0; rg < 4; ++rg) { const int t = 16 * rb + 4 * fq + rg;
                const float hh = fmaf(Pl[cb][rg], Hs, hl[cb][rg]), PP = Pl[cb][rg] * Ps;
                const float G = bf2f(*(const LAS unsigned short*)(L + L_G + t * 256 + dl * 2));
                *(LAS unsigned short*)(L + L_XC + t * 256 + dl * 2) = (unsigned short)f2bf(hh * G);
                *(LAS unsigned short*)(L + L_Y1 + t * 256 + dl * 2) = (unsigned short)f2bf(PP * G);
                if (rg == 3) { ncP[cb] = PP; nch[cb] = hh; } } }
        __syncthreads();
        if (rb == 3 && fq == 3) {
#pragma unroll
            for (int cb = 0; cb < 4; ++cb) { const int dl = 64 * chf + 16 * cb + fr; carry[2 * dl] = ncP[cb]; carry[2 * dl + 1] = nch[cb]; } }
        { const size_t go = (row0 + st) * 1024 + sch;
          const v4u a0 = *(const LAS v4u*)(L + L_XC + st * 256 + scl * 2), a1 = *(const LAS v4u*)(L + L_XC + st * 256 + scl * 2 + 16);
          const v4u b0 = *(const LAS v4u*)(L + L_Y1 + st * 256 + scl * 2), b1 = *(const LAS v4u*)(L + L_Y1 + st * 256 + scl * 2 + 16);
          *(GAS v4u*)(Y0 + go) = a0; *(GAS v4u*)(Y0 + go + 8) = a1; *(GAS v4u*)(Y1 + go) = b0; *(GAS v4u*)(Y1 + go + 8) = b1; }
        if (it + 1 < nitems) STAGE_WRITE(it + 1);
        __syncthreads();
    }
    if (F.tid < 128) {
        if (quarter == 0) F.out[OUT_HS + (size_t)b * 1024 + n * 128 + F.tid] = carry[2 * F.tid + 1];
        else { float* ao = F.agg + ((size_t)(b * 8 + n) * 4 + quarter) * 256; ao[F.tid] = carry[2 * F.tid]; ao[128 + F.tid] = carry[2 * F.tid + 1]; } }
#undef ITEM_ROW0
#undef STAGE_LOAD
#undef STAGE_WRITE
    { const int gw = F.vcu * NWAVES + F.wave, NGW = F.G * NWAVES;
      const bf16* ZKb = zbuf(F, ZK); const bf16* ZVb = zbuf(F, ZV);
      for (int r = gw; r < 9216; r += NGW) {
          const bf16* src; float* dst;
          if (r < 8192) { const int isv = r >> 12, rr = r & 4095, bb = rr >> 9, k = rr & 511; src = (isv ? ZVb : ZKb) + ((size_t)bb * TP + (TP - CROWS) + k) * 1024; dst = F.out + (isv ? OUT_VP : OUT_KP) + (size_t)rr * 1024; }
          else { const int r2 = r - 8192, isv = r2 >> 9, rr = r2 & 511; src = (isv ? ZVb : ZKb) + ((size_t)MP + rr) * 1024; dst = F.out + (isv ? OUT_VS : OUT_KS) + (size_t)rr * 1024; }
#pragma unroll
          for (int hf = 0; hf < 2; ++hf) { const v4u raw = *(const v4u*)(src + hf * 512 + F.lane * 8); float* d = dst + hf * 512 + F.lane * 8;
              *(f32x4*)d = (f32x4){__uint_as_float(raw.x << 16), __uint_as_float(raw.x & 0xffff0000u), __uint_as_float(raw.y << 16), __uint_as_float(raw.y & 0xffff0000u)};
              *(f32x4*)(d + 4) = (f32x4){__uint_as_float(raw.z << 16), __uint_as_float(raw.z & 0xffff0000u), __uint_as_float(raw.w << 16), __uint_as_float(raw.w & 0xffff0000u)}; }
      } }
}
__device__ __forceinline__ void p4_attention(Frame& F, const bf16* Y0, const bf16* Y1, bf16* MG) {
    char* lds = (char*)F.lds;
    const int pair = F.vcu >> 2, quarter = F.vcu & 3, b = pair >> 3, h = pair & 7;
    const int wid = F.wave, lane = F.lane, r32 = lane & 31, hi = lane >> 5, wch = wid >> 1;
    { LAS float* tb = (LAS float*)(F.lds + attn::L_TB);
      for (int i = F.tid; i < 320; i += NWAVES * 64) tb[i] = F.rel_bias[h * 257 + (i < 256 ? i : 256)] * (1.0f / attn::SCALE);
      __syncthreads(); }
    const bf16* wsb = (const bf16*)F.ws;
    const bf16* ZQb = zbuf(F, ZQ); const bf16* ZGBb = zbuf(F, ZGB);
    const long offK = (long)((WS_Z + (size_t)ZK * ZBUF) / 2), offV = (long)((WS_Z + (size_t)ZV * ZBUF) / 2), offCK = (long)(WS_CK / 2), offCV = (long)(WS_CV / 2);
    const float* ag = F.agg + ((size_t)(b * 8 + h) * 4) * 256;
    float hin[4] = {0.f, 0.f, 0.f, 0.f};
    for (int c = 0; c < quarter; ++c) {
#pragma unroll
        for (int d0 = 0; d0 < 4; ++d0) hin[d0] = fmaf(ag[c * 256 + 32 * d0 + r32], hin[d0], ag[c * 256 + 128 + 32 * d0 + r32]); }
    LAS float* hsl = (LAS float*)(F.lds + attn::L_HIN) + F.tid * 4;
#pragma unroll
    for (int d0 = 0; d0 < 4; ++d0) hsl[d0] = hin[d0];
    const int nunits = 8 + (quarter == 0 ? 1 : 0);
    for (int ui = 0; ui < nunits; ++ui) {
        const bool smp = ui >= 8; const int g = 8 * quarter + ui;
        attn::AUnit u; u.wsb = wsb;
        size_t row0;
        if (!smp) { row0 = (size_t)b * TP + 256 * g;
            u.kA = offK + ((long)b * TP + (long)(4 * g - 8) * 64) * 1024 + h * 128; u.vA = offV + ((long)b * TP + (long)(4 * g - 8) * 64) * 1024 + h * 128;
            u.kB = u.kA; u.vB = u.vA; u.tsw = 1 << 30; u.t0 = (8 - 4 * g) > 0 ? (8 - 4 * g) : 0; u.nt = 12; u.nwq = 8; }
        else { row0 = (size_t)MP + b * 64;
            u.kA = offCK + ((long)b * CROWS) * 1024 + h * 128; u.vA = offCV + ((long)b * CROWS) * 1024 + h * 128;
            u.kB = offK + ((long)MP + b * 64) * 1024 + h * 128; u.vB = offV + ((long)MP + b * 64) * 1024 + h * 128; u.tsw = 8; u.t0 = 0; u.nt = 10; u.nwq = 2; }
        u.q = ZQb + row0 * 1024 + h * 128;
        attn::f32x16 o[4]; float rli[16];
        attn::attn_unit(u, lds, o, rli);
        float hw[4];
#pragma unroll
        for (int d0 = 0; d0 < 4; ++d0) hw[d0] = smp ? 0.f : hsl[d0];
        if (wid < u.nwq) {
        int hi_l = hi; asm volatile("" : "+v"(hi_l));
#pragma unroll
        for (int r = 0; r < 16; ++r) { const size_t row = row0 + 32 * wid + attn::crow(r, hi_l);
#pragma unroll
            for (int d0 = 0; d0 < 4; ++d0) { const size_t gi = row * 1024 + h * 128 + 32 * d0 + r32;
                const float val = bf2f(Y0[gi]) + bf2f(Y1[gi]) * hw[d0] + sigmoid_f(bf2f(ZGBb[gi])) * (o[d0][r] * rli[r]);
                MG[gi] = (bf16)f2bf(val); } } }
        if (!smp && g == 31 && wid == 0 && hi == 0) {
#pragma unroll
            for (int d0 = 0; d0 < 4; ++d0) F.out[OUT_HP + (size_t)b * 1024 + h * 128 + 32 * d0 + r32] = fmaf(ag[3 * 256 + 32 * d0 + r32], hsl[d0], ag[3 * 256 + 128 + 32 * d0 + r32]); }
    }
}

struct Args { const float* in[28]; float* out; unsigned char* ws; int ph_lo, ph_hi, li, pad; };
__global__ void __launch_bounds__(NWAVES * 64, 2) mega_fwd(Args args) {
    extern __shared__ __attribute__((aligned(16))) unsigned char lds[];
    Frame F;
    F.lds = (LAS unsigned char*)lds;
    F.MISC = (volatile LAS unsigned*)(F.lds + MISC_OFF);
    F.tid = threadIdx.x; F.lane = F.tid & 63; F.wave = __builtin_amdgcn_readfirstlane(F.tid >> 6);
    F.G = gridDim.x; { const int bx = blockIdx.x; F.vcu = (F.G % 8 == 0) ? (bx % 8) * (F.G / 8) + bx / 8 : bx; }
    unsigned char* ws = args.ws; F.ws = ws; F.out = args.out;
    F.ctl = (gu32*)(ws + WS_CTL);
    F.x_p = args.in[0]; F.x_s = args.in[1]; F.c_p = args.in[2]; F.c_s = args.in[3]; F.cache_k = args.in[4]; F.cache_v = args.in[5]; F.state_conv = args.in[6]; F.state_lru = args.in[7];
    F.w_ada = args.in[8]; F.b_ada = args.in[9]; F.w_in = args.in[10]; F.conv_w = args.in[11]; F.conv_b = args.in[12]; F.w_rg = args.in[13]; F.b_rg = args.in[14]; F.w_ig = args.in[15]; F.b_ig = args.in[16];
    F.lam = args.in[17]; F.rel_bias = args.in[18]; F.w_out = args.in[19]; F.ln1_g = args.in[20]; F.ln1_b = args.in[21]; F.w_up = args.in[22]; F.b_up = args.in[23]; F.w_down = args.in[24]; F.b_down = args.in[25];
    F.ln2_g = args.in[26]; F.ln2_b = args.in[27];
    F.mod = (float*)(ws + WS_MOD); F.agg = (float*)(ws + WS_AGG);
    F.Win_t = (bf16*)(ws + WS_WIN); F.Wout_t = (bf16*)(ws + WS_WOUT); F.Wup_t = (bf16*)(ws + WS_WUP); F.Wdn_t = (bf16*)(ws + WS_WDN); F.Wrg_t = (bf16*)(ws + WS_WRG); F.Wig_t = (bf16*)(ws + WS_WIG);
    F.CK = (bf16*)(ws + WS_CK); F.CV = (bf16*)(ws + WS_CV); F.Z = (bf16*)(ws + WS_Z);
    for (int u = F.tid; u < (LDS_BYTES - LDSCTL_OFF) / 4; u += NWAVES * 64) ((LAS unsigned*)(F.lds + LDSCTL_OFF))[u] = 0u;
    __syncthreads();
    XcdBarrier bar; bar.bar = (unsigned*)(F.ctl + CW_BAR); bar.x = 0; bar.st = nullptr;
    if (N_LAUNCHES == 1) bar = xcd_barrier_post((unsigned*)(F.ctl + CW_BAR), F.MISC + 8);
#define GRID_BAR() do { if (N_LAUNCHES == 1) xcd_barrier(bar); } while (0)
    const int lo = args.ph_lo, hi = args.ph_hi;
#ifndef MK_PHASE_MASK
#define MK_PHASE_MASK 0x3ff
#endif
#define IN(k) (((MK_PHASE_MASK >> (k)) & 1) && lo <= (k) && (k) < hi)
#define BOTH(k) (IN(k) && IN((k) + 1))
#define REP(k) ((MK_REPEAT_PHASE == (k)) ? 2 : 1)
    bf16* U = (bf16*)F.out; bf16* Y0 = (bf16*)F.out; bf16* Y1 = (bf16*)((unsigned char*)F.out + ZBUF); float* R = F.out;
    bf16* MG = (bf16*)(ws + WS_MERGED); bf16* U2 = (bf16*)(ws + WS_U2); float* X1 = (float*)(ws + WS_X1); bf16* HB = (bf16*)(ws + WS_H);

    if (IN(0)) { for (int rep = 0; rep < REP(0); ++rep) { p0_prologue(F); __syncthreads(); } if (BOTH(0)) GRID_BAR(); }
    if (IN(1)) { for (int rep = 0; rep < REP(1); ++rep) p1_upass(F, U); if (BOTH(1)) GRID_BAR(); }
    if (IN(2)) {
        for (int rep = 0; rep < REP(2); ++rep) {
        pg8::Gemm g{U, F.Win_t, M, DIN, DM}; pg8::StaticOrder S; S.init(M, DIN, F.G, (int)blockIdx.x);
        pg8::EpiBf16<0> E{F.Z, 1024, nullptr, 1024, ZBUF / 2, 1.f};
        pg8::gemm_phase<pg8::EpiBf16<0>, pg8::StaticOrder, PG8_ALIGN, PG8_SP2>(F.lds + RING_OFF, g, S, E); }
        if (BOTH(2)) GRID_BAR();
    }
    if (IN(3)) { for (int rep = 0; rep < REP(3); ++rep) { p3_lru(F, Y0, Y1); __syncthreads(); } if (BOTH(3)) GRID_BAR(); }
    if (IN(4)) { for (int rep = 0; rep < REP(4); ++rep) { p4_attention(F, Y0, Y1, MG); __syncthreads(); } if (BOTH(4)) GRID_BAR(); }
    if (IN(5)) {
        for (int rep = 0; rep < REP(5); ++rep) {
        pg8::Gemm g{MG, F.Wout_t, M, DM, DM}; pg8::StaticOrder S; S.init(M, DM, F.G, (int)blockIdx.x);
        pg8::EpiRes E{F.x_p, F.x_s, R, nullptr, F.mod, MOD_G1, MP, ALPHA};
        pg8::gemm_phase<pg8::EpiRes, pg8::StaticOrder, PG8_ALIGN, PG8_SP2>(F.lds + RING_OFF, g, S, E); }
        if (BOTH(5)) GRID_BAR();
    }
    if (IN(6)) { for (int rep = 0; rep < REP(6); ++rep) ln_pass<true>(F, R, X1, U2, F.ln1_g, F.ln1_b); if (BOTH(6)) GRID_BAR(); }
    if (IN(7)) {
        for (int rep = 0; rep < REP(7); ++rep) {
        pg8::Gemm g{U2, F.Wup_t, M, FF, DM}; pg8::StaticOrder S; S.init(M, FF, F.G, (int)blockIdx.x);
        pg8::EpiBf16<2> E{HB, FF, F.b_up, 0, 0, 1.f};
        pg8::gemm_phase<pg8::EpiBf16<2>, pg8::StaticOrder, PG8_ALIGN, PG8_SP2>(F.lds + RING_OFF, g, S, E); }
        if (BOTH(7)) GRID_BAR();
    }
    if (IN(8)) {
        for (int rep = 0; rep < REP(8); ++rep) {
        pg8::Gemm g{HB, F.Wdn_t, M, DM, FF}; pg8::StaticOrder S; S.init(M, DM, F.G, (int)blockIdx.x);
        pg8::EpiRes E{X1, X1 + (size_t)MP * 1024, R, F.b_down, F.mod, MOD_G2, MP, ALPHA};
        pg8::gemm_phase<pg8::EpiRes, pg8::StaticOrder, PG8_ALIGN, PG8_SP2>(F.lds + RING_OFF, g, S, E); }
        if (BOTH(8)) GRID_BAR();
    }
    if (IN(9)) { ln_pass<false>(F, R, R, nullptr, F.ln2_g, F.ln2_b); }
#undef IN
#undef BOTH
#undef REP
}

extern "C" void kernel_launch(void* const* d_in, const int* in_sizes, int n_in, void* d_out, int out_size, void* d_ws, size_t ws_size, hipStream_t stream) {
    static int grid = 0;
    if (grid == 0) {
        if (n_in != 28 || in_sizes[0] != MP * DM || in_sizes[1] != MS * DM || (size_t)out_size != OUT_TOTAL || ws_size < WS_END) {
            fprintf(stderr, "kernel_launch: built for 28 inputs, x_prompt %d, out %zu floats, >= %zu bytes of workspace; got n_in %d, in0 %d, out %d, ws %zu; nothing launched\n", MP * DM, (size_t)OUT_TOTAL, (size_t)WS_END, n_in, n_in > 0 ? in_sizes[0] : -1, out_size, ws_size); grid = -1; return; }
        int dev = 0, cus = 0, per_cu = 0;
        if (hipGetDevice(&dev) != hipSuccess || hipDeviceGetAttribute(&cus, hipDeviceAttributeMultiprocessorCount, dev) != hipSuccess) { fprintf(stderr, "kernel_launch: hipGetDevice / hipDeviceGetAttribute failed\n"); grid = -1; return; }
        if (hipFuncSetAttribute((const void*)mega_fwd, hipFuncAttributeMaxDynamicSharedMemorySize, LDS_BYTES) != hipSuccess) { fprintf(stderr, "kernel_launch: hipFuncSetAttribute(%d B LDS) failed\n", LDS_BYTES); grid = -1; return; }
        if (hipOccupancyMaxActiveBlocksPerMultiprocessor(&per_cu, (const void*)mega_fwd, NWAVES * 64, LDS_BYTES) != hipSuccess || per_cu < 1)
            fprintf(stderr, "kernel_launch: note: occupancy query reports %d workgroups per CU\n", per_cu);
        (void)hipGetLastError();
        grid = cus;
        if (grid != 256) { fprintf(stderr, "kernel_launch: this kernel is built for a 256-CU device (got %d)\n", grid); grid = -1; return; }
    }
    if (grid < 0) return;
    if (hipMemsetAsync((char*)d_ws + WS_CTL, 0, CTL_ZERO_BYTES, stream) != hipSuccess) { fprintf(stderr, "kernel_launch: hipMemsetAsync failed\n"); return; }
    Args a{};
    for (int i = 0; i < 28; ++i) a.in[i] = (const float*)d_in[i];
    a.out = (float*)d_out; a.ws = (unsigned char*)d_ws;
    for (int li = 0; li < N_LAUNCHES; ++li) {
        a.ph_lo = (N_LAUNCHES == 1) ? 0 : li; a.ph_hi = (N_LAUNCHES == 1) ? N_PHASES : li + 1; a.li = li;
        hipLaunchKernelGGL(mega_fwd, dim3(grid), dim3(NWAVES * 64), LDS_BYTES, stream, a);
        const hipError_t le = hipPeekAtLastError();
        if (le != hipSuccess) { fprintf(stderr, "kernel_launch: launch %d failed: %s\n", li, hipGetErrorName(le)); break; }
    }
}
```

```cpp
#include <hip/hip_runtime.h>
#include <hip/hip_bf16.h>
#include <cstdio>
#include <cstdint>
#include <cmath>

namespace pg8 {
#define PG8_LAS __attribute__((address_space(3)))
typedef unsigned short bf16_t;
typedef short bf16x8 __attribute__((ext_vector_type(8)));
typedef float f32x4 __attribute__((ext_vector_type(4)));
typedef unsigned u32x4 __attribute__((ext_vector_type(4)));
constexpr int BM = 256, BK = 64, HALF = 128, HTB = HALF * BK * 2  , STAGE_BYTES = 8 * HTB, NXCD = 8, WGM = 8;

__host__ __device__ __forceinline__ int lds_byte(int r, int c) { const int st = (r >> 4) * 2 + (c >> 5), rr = r & 15, cc = c & 31, ob = rr * 64 + cc * 2; return st * 1024 + (ob ^ (((ob >> 9) & 1) << 5)); }
__host__ __device__ __forceinline__ void stage_rc(int b, int& R, int& C) { const int st = b / 1024, sb = b % 1024, swz = sb ^ (((sb >> 9) & 1) << 5); R = (st >> 1) * 16 + swz / 64; C = (st & 1) * 32 + (swz % 64) / 2; }
__host__ __device__ __forceinline__ int perm32(int rho) { const int n = rho >> 4, i = rho & 15; return 8 * (i >> 2) + 4 * n + (i & 3); }

struct Unit { int pm, pn; };
struct Gemm { const bf16_t* A; const bf16_t* Bt; int M, N, K; };

struct StaticOrder {
    int nM, nN, nwg, G, c;
    __host__ __device__ void init(int M, int N, int G_, int c_) { nM = M / BM; nN = N / BM; nwg = nM * nN; G = G_; c = c_; }
    __host__ __device__ bool next(int i, Unit& u) const {
        const long L = (long)i * G + c; if (L >= nwg) return false;
        int wgid = (int)L; { const int q = nwg / NXCD, r = nwg % NXCD, xcd = wgid % NXCD, off = wgid / NXCD; wgid = (xcd < r ? xcd * (q + 1) : r * (q + 1) + (xcd - r) * q) + off; }
        const int nig = WGM * nN, gid = wgid / nig, fm = gid * WGM, gsz = (nM - fm) < WGM ? (nM - fm) : WGM;
        u.pm = fm + ((wgid % nig) % gsz); u.pn = (wgid % nig) / gsz; return true;
    }
    __device__ __forceinline__ void a_ready(const Unit&) const {}
    __device__ __forceinline__ void done(const Unit&) const {}
};

__device__ __forceinline__ unsigned cvt_pk_bf16(float lo, float hi) { unsigned r; asm volatile("v_cvt_pk_bf16_f32 %0, %1, %2" : "=v"(r) : "v"(lo), "v"(hi)); return r; }
typedef float f32x2 __attribute__((ext_vector_type(2)));
__device__ __forceinline__ f32x2 gelu_pk(f32x2 v) {
    const f32x2 av = __builtin_elementwise_abs(v), d = av * 0.2316418882f + 1.0f;
    f32x2 t; t.x = __builtin_amdgcn_rcpf(d.x); t.y = __builtin_amdgcn_rcpf(d.y);
    f32x2 q = t * 0.5307027145f + (-0.7265760135f); q = q * t + 0.7107068705f; q = q * t + (-0.142248368f); q = q * t + 0.127414796f; q = q * t;
    const f32x2 s = (v * v) * (-0.72134752044f);
    f32x2 e; e.x = __builtin_amdgcn_exp2f(s.x); e.y = __builtin_amdgcn_exp2f(s.y);
    const f32x2 m = v * (q * e), r = v - m;
    f32x2 o; o.x = v.x < 0.f ? m.x : r.x; o.y = v.y < 0.f ? m.y : r.y; return o;
}

template <int ACT  > struct EpiBf16 {
    static constexpr bool PERM = true, AFTER_DRAIN = false; static_assert(ACT == 0 || ACT == 1 || ACT == 2, "EpiBf16: ACT is 0 (none), 1 (gelu_pk) or 2 (relu squared)");
    bf16_t* O; int ldc; const float* bias; int split_cols; size_t split_stride; float scale0;
    __device__ __forceinline__ void operator()(const f32x4 (&acc)[2][2][4][2], const Unit& u, int wr, int wc, int fr, int fq) const {
        const int row0 = u.pm * BM + wr * 64 + fr; int colt = u.pn * BM; bf16_t* base = O;
        float sc = 1.f; if (split_cols) { const int t = colt / split_cols; base += (size_t)t * split_stride; colt -= t * split_cols; if (t == 0) sc = scale0; }
        const int col0 = colt + wc * 32 + 8 * fq, bcol0 = u.pn * BM + wc * 32 + 8 * fq;
        f32x4 bv[2][2];
#pragma unroll
        for (int bj = 0; bj < 2; ++bj)
#pragma unroll
            for (int n = 0; n < 2; ++n) bv[bj][n] = bias ? *(const f32x4*)(bias + bcol0 + bj * HALF + 4 * n) : (f32x4){0.f, 0.f, 0.f, 0.f};
#pragma unroll
        for (int ai = 0; ai < 2; ++ai)
#pragma unroll
            for (int m = 0; m < 4; ++m) { bf16_t* rowp = base + (size_t)(row0 + ai * HALF + m * 16) * ldc + col0;
#pragma unroll
                for (int bj = 0; bj < 2; ++bj) { f32x4 v0 = acc[ai][bj][m][0] + bv[bj][0], v1 = acc[ai][bj][m][1] + bv[bj][1];
                    if (ACT == 1) { f32x2 a = gelu_pk((f32x2){v0[0], v0[1]}), b = gelu_pk((f32x2){v0[2], v0[3]}), c = gelu_pk((f32x2){v1[0], v1[1]}), d = gelu_pk((f32x2){v1[2], v1[3]});
                        v0 = (f32x4){a.x, a.y, b.x, b.y}; v1 = (f32x4){c.x, c.y, d.x, d.y}; }
                    if (ACT == 2) { _Pragma("unroll") for (int e_ = 0; e_ < 4; ++e_) { const float a_ = fmaxf(v0[e_], 0.f), b_ = fmaxf(v1[e_], 0.f); v0[e_] = a_ * a_; v1[e_] = b_ * b_; } }
                    v0 = v0 * sc; v1 = v1 * sc; u32x4 w; w.x = cvt_pk_bf16(v0[0], v0[1]); w.y = cvt_pk_bf16(v0[2], v0[3]); w.z = cvt_pk_bf16(v1[0], v1[1]); w.w = cvt_pk_bf16(v1[2], v1[3]);
                    *(u32x4*)(rowp + bj * HALF) = w; } }
    }
};


struct EpiRes {
    static constexpr bool PERM = false, AFTER_DRAIN = false;
    const float* xin_p; const float* xin_s; float* out; const float* bias; const float* mod; int goff; int mp; float alpha;
    __device__ __forceinline__ void operator()(const f32x4 (&acc)[2][2][4][2], const Unit& u, int wr, int wc, int fr, int fq) const {
        const int col0 = u.pn * BM + wc * 32 + 4 * fq;
        f32x4 bv[2][2];
#pragma unroll
        for (int bj = 0; bj < 2; ++bj)
#pragma unroll
            for (int n = 0; n < 2; ++n) bv[bj][n] = bias ? *(const f32x4*)(bias + col0 + bj * HALF + n * 16) : (f32x4){0.f, 0.f, 0.f, 0.f};
#pragma unroll
        for (int ai = 0; ai < 2; ++ai) {
            const int rowbase = u.pm * BM + ai * HALF + wr * 64;
            const int bidx = rowbase < mp ? (rowbase >> 13) : 8 + ((rowbase - mp) >> 6);
            const float* gp = mod + (size_t)bidx * 6144 + goff + col0;
            f32x4 gv[2][2];
#pragma unroll
            for (int bj = 0; bj < 2; ++bj)
#pragma unroll
                for (int n = 0; n < 2; ++n) gv[bj][n] = *(const f32x4*)(gp + bj * HALF + n * 16) + 1.0f;
#pragma unroll
            for (int m = 0; m < 4; ++m) {
                const int row = rowbase + m * 16 + fr;
                const float* xrow = (row < mp ? xin_p + (size_t)row * 1024 : xin_s + (size_t)(row - mp) * 1024) + col0;
                float* orow = out + (size_t)row * 1024 + col0;
#pragma unroll
                for (int bj = 0; bj < 2; ++bj)
#pragma unroll
                    for (int n = 0; n < 2; ++n) {
                        const f32x4 xv = *(const f32x4*)(xrow + bj * HALF + n * 16);
                        const f32x4 o = xv * alpha + gv[bj][n] * (acc[ai][bj][m][n] + bv[bj][n]);
                        *(f32x4*)(orow + bj * HALF + n * 16) = o;
                    }
                if (m & 1) asm volatile("" ::: "memory");
            }
        }
    }
};

template <class Epi, class Sched, bool ALIGN_EPI = false, bool SP2 = false>
__device__ __forceinline__ void gemm_phase(PG8_LAS unsigned char* lds, const Gemm g, const Sched& S, const Epi& E) {
    const int tid = threadIdx.x, wid = __builtin_amdgcn_readfirstlane(tid >> 6), lane = tid & 63, wr = wid >> 2, wc = wid & 3, fr = lane & 15, fq = lane >> 4;
    const int K = g.K, nt = K / BK;
    unsigned voffA[2], voffB[2];
#pragma unroll
    for (int i = 0; i < 2; ++i) { int R, C; stage_rc(tid * 16 + i * 8192, R, C); const int Rb = Epi::PERM ? ((R & ~31) + perm32(R & 31)) : R;
        voffA[i] = (unsigned)(R * K + C) * 2u; voffB[i] = (unsigned)(Rb * K + C) * 2u; }
    const size_t kstep = (size_t)(BK * 2);
    const size_t hstep = (size_t)HALF * K * 2;
    const size_t tstep = 2 * hstep;
    const unsigned ldsw = (unsigned)wid * 1024u;
    const int aoff = lds_byte(wr * 64 + fr, fq * 8), boff = lds_byte(wc * 32 + fr, fq * 8);
#define PG8_SA(b, h) (((b) * 2 + (h)) * HTB)
#define PG8_SB(b, h) ((4 + (b) * 2 + (h)) * HTB)
#define PG8_STAGE(bufoff, gbase, voff) do { _Pragma("unroll") for (int _i = 0; _i < 2; ++_i) \
        __builtin_amdgcn_global_load_lds((const unsigned*)((const char*)(gbase) + (voff)[_i]), (PG8_LAS unsigned*)(lds + (bufoff) + ldsw + _i * 8192), 16, 0, 0); } while (0)
#define PG8_LDA(dst, b, h) do { _Pragma("unroll") for (int m = 0; m < 4; ++m) _Pragma("unroll") for (int k = 0; k < 2; ++k) dst[m][k] = *(const PG8_LAS bf16x8*)(lds + PG8_SA(b, h) + aoff + m * 2048 + k * 1024); } while (0)
#define PG8_LDB(dst, b, h) do { _Pragma("unroll") for (int n = 0; n < 2; ++n) _Pragma("unroll") for (int k = 0; k < 2; ++k) dst[n][k] = *(const PG8_LAS bf16x8*)(lds + PG8_SB(b, h) + boff + n * 2048 + k * 1024); } while (0)
#define PG8_MMA(ai, bj, At, Bt) do { __builtin_amdgcn_s_setprio(1); _Pragma("unroll") for (int m = 0; m < 4; ++m) _Pragma("unroll") for (int n = 0; n < 2; ++n) _Pragma("unroll") for (int k = 0; k < 2; ++k) \
        acc[ai][bj][m][n] = __builtin_amdgcn_mfma_f32_16x16x32_bf16(Bt[n][k], At[m][k], acc[ai][bj][m][n], 0, 0, 0); __builtin_amdgcn_s_setprio(0); } while (0)
#define PG8_WAIT_V(n) asm volatile("s_waitcnt vmcnt(" #n ")" ::: "memory")
#define PG8_WAIT_L(n) asm volatile("s_waitcnt lgkmcnt(" #n ")" ::: "memory")
#define PG8_BAR __builtin_amdgcn_s_barrier()
#define PG8_SCHED __builtin_amdgcn_sched_barrier(0)
    Unit cur, nxt; int ui = 0;
    if (!S.next(0, cur)) return;
    f32x4 acc[2][2][4][2];
#pragma unroll
    for (int a = 0; a < 2; ++a)
#pragma unroll
        for (int b = 0; b < 2; ++b)
#pragma unroll
            for (int m = 0; m < 4; ++m)
#pragma unroll
                for (int n = 0; n < 2; ++n) acc[a][b][m][n] = (f32x4){0.f, 0.f, 0.f, 0.f};
    bf16x8 At[4][2], B0[2][2], B1[2][2];
    const char* cA = (const char*)g.A + (size_t)cur.pm * tstep; const char* cB = (const char*)g.Bt + (size_t)cur.pn * tstep;
    S.a_ready(cur);
    if constexpr (SP2) {
        PG8_STAGE(PG8_SB(0, 0), cB, voffB); PG8_STAGE(PG8_SB(0, 1), cB + hstep, voffB); PG8_STAGE(PG8_SA(0, 0), cA, voffA); PG8_STAGE(PG8_SA(0, 1), cA + hstep, voffA);
        if (wr == 1) PG8_BAR;
        PG8_WAIT_V(2); PG8_BAR;
        PG8_STAGE(PG8_SB(1, 0), cB + kstep, voffB); PG8_STAGE(PG8_SA(1, 0), cA + kstep, voffA); PG8_STAGE(PG8_SB(1, 1), cB + hstep + kstep, voffB);
        PG8_WAIT_V(6); PG8_BAR;
    } else {
        PG8_STAGE(PG8_SB(0, 0), cB, voffB); PG8_STAGE(PG8_SA(0, 0), cA, voffA); PG8_STAGE(PG8_SB(0, 1), cB + hstep, voffB); PG8_STAGE(PG8_SA(0, 1), cA + hstep, voffA);
        if (wr == 1) PG8_BAR;
        PG8_WAIT_V(4); PG8_BAR;
        PG8_STAGE(PG8_SB(1, 0), cB + kstep, voffB); PG8_STAGE(PG8_SA(1, 0), cA + kstep, voffA); PG8_STAGE(PG8_SB(1, 1), cB + hstep + kstep, voffB);
        PG8_WAIT_V(6); PG8_BAR;
    }
    for (;;) {
        const bool has_next = S.next(ui + 1, nxt);
        const char* nA = has_next ? (const char*)g.A + (size_t)nxt.pm * tstep : cA; const char* nB = has_next ? (const char*)g.Bt + (size_t)nxt.pn * tstep : cB;
        for (int t = 0; t < nt; t += 2) {
            const bool last = (t == nt - 2);
            const char* a1 = cA + (size_t)(t + 1) * kstep;
            const char* a2 = last ? nA : cA + (size_t)(t + 2) * kstep; const char* b2 = last ? nB : cB + (size_t)(t + 2) * kstep;
            const char* a3 = a2 + kstep; const char* b3 = b2 + kstep;
            if (last && has_next) S.a_ready(nxt);
            if constexpr (SP2) {
            PG8_LDB(B0, 0, 0); PG8_LDB(B1, 0, 1); PG8_SCHED; PG8_LDA(At, 0, 0); PG8_STAGE(PG8_SA(1, 1), a1 + hstep, voffA);
            PG8_WAIT_V(8); PG8_WAIT_L(0); PG8_BAR; PG8_MMA(0, 0, At, B0); PG8_MMA(0, 1, At, B1); PG8_BAR; PG8_SCHED;
            PG8_LDA(At, 0, 1); PG8_STAGE(PG8_SB(0, 0), b2, voffB); PG8_STAGE(PG8_SB(0, 1), b2 + hstep, voffB); PG8_STAGE(PG8_SA(0, 0), a2, voffA);
            PG8_WAIT_V(8); PG8_WAIT_L(0); PG8_BAR; PG8_MMA(1, 0, At, B0); PG8_MMA(1, 1, At, B1); PG8_BAR; PG8_SCHED;
            PG8_LDB(B0, 1, 0); PG8_LDB(B1, 1, 1); PG8_SCHED; PG8_LDA(At, 1, 0); PG8_STAGE(PG8_SA(0, 1), a2 + hstep, voffA);
            PG8_WAIT_V(8); PG8_WAIT_L(0); PG8_BAR; PG8_MMA(0, 0, At, B0); PG8_MMA(0, 1, At, B1); PG8_BAR; PG8_SCHED;
            PG8_LDA(At, 1, 1); PG8_STAGE(PG8_SB(1, 0), b3, voffB); PG8_STAGE(PG8_SB(1, 1), b3 + hstep, voffB); PG8_STAGE(PG8_SA(1, 0), a3, voffA);
            PG8_WAIT_V(8); PG8_WAIT_L(0); PG8_BAR; PG8_MMA(1, 0, At, B0); PG8_MMA(1, 1, At, B1); PG8_BAR; PG8_SCHED;
            } else {
            PG8_LDB(B0, 0, 0); PG8_SCHED; PG8_LDA(At, 0, 0); PG8_STAGE(PG8_SA(1, 1), a1 + hstep, voffA);
            PG8_WAIT_L(8); PG8_BAR; PG8_WAIT_L(0); PG8_MMA(0, 0, At, B0); PG8_BAR; PG8_SCHED;
            PG8_LDB(B1, 0, 1); PG8_STAGE(PG8_SB(0, 0), b2, voffB);
            PG8_BAR; PG8_WAIT_L(0); PG8_MMA(0, 1, At, B1); PG8_BAR;
            PG8_LDA(At, 0, 1); PG8_STAGE(PG8_SA(0, 0), a2, voffA);
            PG8_BAR; PG8_WAIT_L(0); PG8_MMA(1, 0, At, B0); PG8_BAR; PG8_SCHED;
            PG8_STAGE(PG8_SB(0, 1), b2 + hstep, voffB);
            PG8_WAIT_V(6); PG8_BAR; PG8_MMA(1, 1, At, B1); PG8_BAR;
            PG8_LDB(B0, 1, 0); PG8_SCHED; PG8_LDA(At, 1, 0); PG8_STAGE(PG8_SA(0, 1), a2 + hstep, voffA);
            PG8_WAIT_L(8); PG8_BAR; PG8_WAIT_L(0); PG8_MMA(0, 0, At, B0); PG8_BAR; PG8_SCHED;
            PG8_LDB(B1, 1, 1); PG8_STAGE(PG8_SB(1, 0), b3, voffB);
            PG8_BAR; PG8_WAIT_L(0); PG8_MMA(0, 1, At, B1); PG8_BAR;
            PG8_LDA(At, 1, 1); PG8_STAGE(PG8_SA(1, 0), a3, voffA);
            PG8_BAR; PG8_WAIT_L(0); PG8_MMA(1, 0, At, B0); PG8_BAR; PG8_SCHED;
            PG8_STAGE(PG8_SB(1, 1), b3 + hstep, voffB);
            PG8_WAIT_V(6); PG8_BAR; PG8_MMA(1, 1, At, B1); PG8_BAR;
            }
        }
        if constexpr (ALIGN_EPI) { if (wr == 0) PG8_BAR; }
        if constexpr (!Epi::AFTER_DRAIN) { E(acc, cur, wr, wc, fr, fq); S.done(cur); }
        if (!has_next) break;
#pragma unroll
        for (int a = 0; a < 2; ++a)
#pragma unroll
            for (int b = 0; b < 2; ++b)
#pragma unroll
                for (int m = 0; m < 4; ++m)
#pragma unroll
                    for (int n = 0; n < 2; ++n) acc[a][b][m][n] = (f32x4){0.f, 0.f, 0.f, 0.f};
        cur = nxt; cA = nA; cB = nB; ++ui;
        if constexpr (ALIGN_EPI) { if (wr == 1) PG8_BAR; }
    }
    PG8_WAIT_V(0);
    if constexpr (!ALIGN_EPI) { if (wr == 0) PG8_BAR; }
    PG8_BAR;
    if constexpr (Epi::AFTER_DRAIN) { E.fused(acc, cur, wr, wc, fr, fq, lds, wid, lane); S.done(cur); }
#undef PG8_SA
#undef PG8_SB
#undef PG8_STAGE
#undef PG8_LDA
#undef PG8_LDB
#undef PG8_MMA
#undef PG8_WAIT_V
#undef PG8_WAIT_L
#undef PG8_BAR
#undef PG8_SCHED
}
}


#ifndef PG8_SP2
#define PG8_SP2 true
#endif
#ifndef PG8_ALIGN
#define PG8_ALIGN true
#endif


namespace attn {
using bf16 = unsigned short;
using bf16x8 = __attribute__((ext_vector_type(8))) short;
using s16x4  = __attribute__((ext_vector_type(4))) short;
using f32x16 = __attribute__((ext_vector_type(16))) float;
using u32x4  = __attribute__((ext_vector_type(4))) unsigned;
constexpr int D = 128, NW = 8, QBLK = 32, KVBLK = 64;
constexpr float SCALE = 0.088388347648318440f;
constexpr float THR = 8.f;
constexpr int SHM_V = KVBLK * D * 2, SHM_K = KVBLK * D * 2;
constexpr int L_V = 0, L_K = 2 * SHM_V, L_WS = 2 * SHM_V + 2 * SHM_K, L_TB = L_WS + NW * 64 * 4, L_HIN = L_TB + 1280, ATTN_LDS = L_HIN + 512;
constexpr long TILE_ELEMS = (long)KVBLK * 1024;
#define KSWZ(row, colB) ((row) * 256 + ((colB) ^ (((row) & 7) << 4)))
#define SBAR() __builtin_amdgcn_sched_barrier(0)
__device__ __forceinline__ int crow(int r, int hi) { return (r & 3) + 8 * (r >> 2) + 4 * hi; }
__device__ __forceinline__ unsigned cvtpk(float lo, float hi) { unsigned r; asm volatile("v_cvt_pk_bf16_f32 %0, %1, %2" : "=v"(r) : "v"(lo), "v"(hi)); return r; }
__device__ __forceinline__ float bf2f(unsigned short v) { return __uint_as_float(((unsigned)v) << 16); }

__device__ __forceinline__ void partialSM(f32x16& p0, f32x16& p1, float& m_reg, float& mn, float& alpha) {
  constexpr float C = SCALE * 1.4426950408889634f;
  float pmax = p0[0];
#pragma unroll
  for (int r = 1; r < 16; ++r) pmax = fmaxf(pmax, p0[r]);
#pragma unroll
  for (int r = 0; r < 16; ++r) pmax = fmaxf(pmax, p1[r]);
  { auto rr = __builtin_amdgcn_permlane32_swap(__float_as_uint(pmax), __float_as_uint(pmax), false, false);
    pmax = fmaxf(__uint_as_float(rr[0]), __uint_as_float(rr[1])); }
  if (__builtin_expect(__all(pmax - m_reg <= THR / SCALE), 1)) { mn = m_reg; alpha = 1.f; }
  else { mn = fmaxf(m_reg, pmax); alpha = __builtin_amdgcn_exp2f((m_reg - mn) * C); m_reg = mn; }
  float mnC = -mn * C;
#pragma unroll
  for (int r = 0; r < 16; ++r) p0[r] = fmaf(p0[r], C, mnC);
#pragma unroll
  for (int r = 0; r < 16; ++r) p1[r] = fmaf(p1[r], C, mnC);
#pragma unroll
  for (int r = 0; r < 16; ++r) p0[r] = __builtin_amdgcn_exp2f(p0[r]);
}
__device__ __forceinline__ void finishSM(f32x16& p0, f32x16& p1, float alpha, float& l_reg, bf16x8& pa0, bf16x8& pa1, bf16x8& pa2, bf16x8& pa3) {
#pragma unroll
  for (int r = 0; r < 16; ++r) p1[r] = __builtin_amdgcn_exp2f(p1[r]);
  float ps = 0;
#pragma unroll
  for (int r = 0; r < 16; ++r) ps += p0[r];
#pragma unroll
  for (int r = 0; r < 16; ++r) ps += p1[r];
  { auto rr = __builtin_amdgcn_permlane32_swap(__float_as_uint(ps), __float_as_uint(ps), false, false);
    ps = __uint_as_float(rr[0]) + __uint_as_float(rr[1]); }
  l_reg = l_reg * alpha + ps;
#define PK4(P, BASE, OUT) do { unsigned a0 = cvtpk(P[BASE + 0], P[BASE + 1]), a1 = cvtpk(P[BASE + 2], P[BASE + 3]);   \
    unsigned b0 = cvtpk(P[BASE + 4], P[BASE + 5]), b1 = cvtpk(P[BASE + 6], P[BASE + 7]);                              \
    auto r0 = __builtin_amdgcn_permlane32_swap(a0, b0, false, false); auto r1 = __builtin_amdgcn_permlane32_swap(a1, b1, false, false); \
    u32x4 w = {r0[0], r1[0], r0[1], r1[1]}; OUT = *reinterpret_cast<bf16x8*>(&w); } while (0)
  PK4(p0, 0, pa0); PK4(p0, 8, pa1); PK4(p1, 0, pa2); PK4(p1, 8, pa3);
#undef PK4
}
__device__ __forceinline__ void bias_init(f32x16& p0, f32x16& p1, int d, int qin, int hi, const float* tb) {
  if (d < 0 || d > 8) {
#pragma unroll
    for (int r = 0; r < 16; ++r) { p0[r] = -INFINITY; p1[r] = -INFINITY; } }
  else if (d >= 3) { const float c = tb[256];
#pragma unroll
    for (int r = 0; r < 16; ++r) { p0[r] = c; p1[r] = c; } }
  else { const float* tp = tb + (64 * d + qin + 128 - 4 * hi - 95);
#pragma unroll
    for (int r = 0; r < 16; ++r) { const int kv = (r & 3) + 8 * (r >> 2); p0[r] = tp[95 - kv]; p1[r] = tp[95 - kv - 32]; } }
}
__device__ __forceinline__ void qkt(f32x16& p0, f32x16& p1, const char* Ks, const bf16x8* qr, int r32, int hi) {
  asm volatile("" : "+v"(r32));
#pragma unroll
  for (int d0 = 0; d0 < 8; ++d0) { int cb = (d0 * 16 + hi * 8) * 2;
    bf16x8 b0 = *reinterpret_cast<const bf16x8*>(Ks + KSWZ(r32, cb));
    bf16x8 b1 = *reinterpret_cast<const bf16x8*>(Ks + KSWZ(32 + r32, cb));
    p0 = __builtin_amdgcn_mfma_f32_32x32x16_bf16(b0, qr[d0], p0, 0, 0, 0);
    p1 = __builtin_amdgcn_mfma_f32_32x32x16_bf16(b1, qr[d0], p1, 0, 0, 0); }
}
__device__ __forceinline__ int v_st(int k, int c) { const int kk = (k & ~0xC) | ((k & 4) << 1) | ((k & 8) >> 1); return ((kk >> 3) * 4 + (c >> 5)) * 512 + ((kk & 7) * 32 + (c & 31)) * 2; }
__device__ __forceinline__ int v_rd_base(int lane) { return ((lane & 3) << 3) | (((lane >> 2) & 3) << 6) | (((lane >> 4) & 1) << 5) | (((lane >> 5) & 1) << 8); }
constexpr int v_rd_off(int d0, int ks, int half) { return d0 * 512 + ks * 4096 + half * 2048; }
template <int OFF> __device__ __forceinline__ s16x4 tr_read(int vb) {
  s16x4 r; asm volatile("ds_read_b64_tr_b16 %0, %1 offset:%2" : "=&v"(r) : "v"(vb), "i"(OFF) : "memory"); return r;
}
template <int D0> __device__ __forceinline__ void pv_one(f32x16& od, int vb, bf16x8 pa0, bf16x8 pa1, bf16x8 pa2, bf16x8 pa3) {
  const s16x4 l0 = tr_read<v_rd_off(D0, 0, 0)>(vb), h0 = tr_read<v_rd_off(D0, 0, 1)>(vb), l1 = tr_read<v_rd_off(D0, 1, 0)>(vb), h1 = tr_read<v_rd_off(D0, 1, 1)>(vb);
  const s16x4 l2 = tr_read<v_rd_off(D0, 2, 0)>(vb), h2 = tr_read<v_rd_off(D0, 2, 1)>(vb), l3 = tr_read<v_rd_off(D0, 3, 0)>(vb), h3 = tr_read<v_rd_off(D0, 3, 1)>(vb);
  asm volatile("s_waitcnt lgkmcnt(0)" ::: "memory"); SBAR();
#define PK(L, H) (bf16x8){L[0], L[1], L[2], L[3], H[0], H[1], H[2], H[3]}
  od = __builtin_amdgcn_mfma_f32_32x32x16_bf16(pa0, PK(l0, h0), od, 0, 0, 0);
  od = __builtin_amdgcn_mfma_f32_32x32x16_bf16(pa1, PK(l1, h1), od, 0, 0, 0);
  od = __builtin_amdgcn_mfma_f32_32x32x16_bf16(pa2, PK(l2, h2), od, 0, 0, 0);
  od = __builtin_amdgcn_mfma_f32_32x32x16_bf16(pa3, PK(l3, h3), od, 0, 0, 0);
#undef PK
}
__device__ __forceinline__ void pv_d0(f32x16* o, int vb, bf16x8 pa0, bf16x8 pa1, bf16x8 pa2, bf16x8 pa3) {
  pv_one<0>(o[0], vb, pa0, pa1, pa2, pa3); pv_one<1>(o[1], vb, pa0, pa1, pa2, pa3); pv_one<2>(o[2], vb, pa0, pa1, pa2, pa3); pv_one<3>(o[3], vb, pa0, pa1, pa2, pa3);
}

struct AUnit {
  const bf16* wsb;
  const bf16* q;
  long kA, vA;
  long kB, vB;
  int tsw, t0, nt, nwq;
};
struct SReg { bf16x8 vs0, vs1, ks0, ks1; };
__device__ __forceinline__ void sload(const AUnit& u, int t, SReg& s, int tid) {
  const int sr = tid >> 4, sc = (tid & 15) * 8;
  const long ko = (t < u.tsw) ? u.kA + (long)t * TILE_ELEMS : u.kB, vo = (t < u.tsw) ? u.vA + (long)t * TILE_ELEMS : u.vB;
  const bf16* kp = u.wsb + ko + (long)sr * 1024 + sc; const bf16* vp = u.wsb + vo + (long)sr * 1024 + sc;
  s.vs0 = *reinterpret_cast<const bf16x8*>(vp); s.vs1 = *reinterpret_cast<const bf16x8*>(vp + 32 * 1024);
  s.ks0 = *reinterpret_cast<const bf16x8*>(kp); s.ks1 = *reinterpret_cast<const bf16x8*>(kp + 32 * 1024);
}
__device__ __forceinline__ void attn_prefetch(const AUnit& u, SReg (&sr_)[2]) { sload(u, u.t0, sr_[0], threadIdx.x); sload(u, u.t0 + 1, sr_[1], threadIdx.x); }
__device__ __forceinline__ void attn_unit(const AUnit& u, char* lds, SReg (&sr_)[2], f32x16 (&o)[4], float (&rli)[16]) {
  const int tid = threadIdx.x, wid = __builtin_amdgcn_readfirstlane(tid >> 6), lane = tid & 63, r32 = lane & 31, hi = lane >> 5;
  char* V_lds = lds + L_V; char* K_lds = lds + L_K;
  float* wsf = (float*)(lds + L_WS) + wid * 64; float* li_l = wsf; float* al_l = wsf + 32;
  const float* tb = (const float*)(lds + L_TB);
  float m_reg = -1e30f, l_reg = 0; bf16x8 qr[8];
#pragma unroll
  for (int d = 0; d < 4; ++d) o[d] = f32x16{};
  const bool wq = wid < u.nwq;
  const int wrow = wq ? wid * QBLK : (wid & 1) * QBLK;
  const bf16* Qw = u.q + (long)(wrow + r32) * 1024 + hi * 8;
#pragma unroll
  for (int d0 = 0; d0 < 8; ++d0) qr[d0] = *reinterpret_cast<const bf16x8*>(Qw + d0 * 16);
  const int sr = tid >> 4, sc = (tid & 15) * 8, vst0 = v_st(sr, sc), vst1 = v_st(32 + sr, sc);
  const int vb0 = (int)(uintptr_t)V_lds + v_rd_base(lane);
  const int qin = (wid & 1) * QBLK + r32, wch = wid >> 1;
#define SWRITE(b, i) do { *(bf16x8*)(V_lds + (b) * SHM_V + vst0) = sr_[i].vs0; *(bf16x8*)(V_lds + (b) * SHM_V + vst1) = sr_[i].vs1; int kc = sc * 2; \
    *(bf16x8*)(K_lds + (b) * SHM_K + KSWZ(sr, kc)) = sr_[i].ks0; *(bf16x8*)(K_lds + (b) * SHM_K + KSWZ(32 + sr, kc)) = sr_[i].ks1; } while (0)
#define SWAIT() asm volatile("s_waitcnt vmcnt(4)" ::: "memory")
#define RESC(a) do { if (__any((a) < 1.f)) { if (hi == 0) al_l[r32] = (a); asm volatile("s_waitcnt lgkmcnt(0)" ::: "memory"); \
    _Pragma("unroll") for (int d = 0; d < 4; ++d) _Pragma("unroll") for (int r = 0; r < 16; ++r) o[d][r] *= al_l[crow(r, hi)]; } } while (0)
#define DIST(t) (wch + 8 - (t))
#define ACT(t) (true)
#define ANY(t) (true)
  f32x16 pA0, pA1, pB0, pB1; float mnA = 0.f, mnB = 0.f, alA = 1.f, alB = 1.f; bf16x8 pa0, pa1, pa2, pa3; const int NT = u.nt, T0 = u.t0;
#pragma unroll
  for (int r = 0; r < 16; ++r) { pA0[r] = 0.f; pB0[r] = 0.f; pA1[r] = -INFINITY; pB1[r] = -INFINITY; }
  constexpr int SE = 0, SO = 1;
  SWRITE(0, SE); __syncthreads();
  if (ACT(T0)) { bias_init(pA0, pA1, DIST(T0), qin, hi, tb); qkt(pA0, pA1, K_lds, qr, r32, hi); partialSM(pA0, pA1, m_reg, mnA, alA); }
  sload(u, T0 + 2, sr_[SE], tid);
  SWAIT(); SWRITE(1, SO); __syncthreads();
  for (int j = T0 + 1; j + 1 < NT; j += 2) {
    const bool any1 = ANY(j), any2 = ANY(j + 1);
    SBAR(); if (any1) { bias_init(pB0, pB1, DIST(j), qin, hi, tb); qkt(pB0, pB1, K_lds + SHM_K, qr, r32, hi);
      finishSM(pA0, pA1, alA, l_reg, pa0, pa1, pa2, pa3); } SBAR();
    sload(u, j + 2, sr_[SO], tid); SBAR();
    if (any1) { pv_d0(o, vb0, pa0, pa1, pa2, pa3); partialSM(pB0, pB1, m_reg, mnB, alB); }
    __syncthreads(); SWAIT(); SWRITE(0, SE);
    if (any1) RESC(alB);
    __syncthreads();
    SBAR(); if (any2) { bias_init(pA0, pA1, DIST(j + 1), qin, hi, tb); qkt(pA0, pA1, K_lds, qr, r32, hi);
      finishSM(pB0, pB1, alB, l_reg, pa0, pa1, pa2, pa3); } SBAR();
    if (j + 3 < NT) sload(u, j + 3, sr_[SE], tid); SBAR();
    if (any2) { pv_d0(o, vb0 + SHM_V, pa0, pa1, pa2, pa3); partialSM(pA0, pA1, m_reg, mnA, alA); }
    __syncthreads(); SWAIT(); SWRITE(1, SO);
    if (any2) RESC(alA);
    __syncthreads();
  }
  if (ANY(NT - 1)) {
    SBAR(); bias_init(pB0, pB1, DIST(NT - 1), qin, hi, tb); qkt(pB0, pB1, K_lds + SHM_K, qr, r32, hi);
    finishSM(pA0, pA1, alA, l_reg, pa0, pa1, pa2, pa3); SBAR();
    pv_d0(o, vb0, pa0, pa1, pa2, pa3); partialSM(pB0, pB1, m_reg, mnB, alB);
    RESC(alB);
    finishSM(pB0, pB1, alB, l_reg, pa0, pa1, pa2, pa3); SBAR();
    pv_d0(o, vb0 + SHM_V, pa0, pa1, pa2, pa3); }
  if (hi == 0) li_l[r32] = l_reg; asm volatile("s_waitcnt lgkmcnt(0)" ::: "memory");
#pragma unroll
  for (int r = 0; r < 16; ++r) rli[r] = __builtin_amdgcn_rcpf(li_l[crow(r, hi)]);
  __syncthreads();
#undef SWRITE
#undef SWAIT
#undef RESC
#undef DIST
#undef ACT
#undef ANY
}
#undef SBAR
}

#define GAS __attribute__((address_space(1)))
#define LAS __attribute__((address_space(3)))
typedef unsigned short bf16;
typedef unsigned v4u __attribute__((ext_vector_type(4)));
typedef float f32x4 __attribute__((ext_vector_type(4)));
typedef short bf16x8 __attribute__((ext_vector_type(8)));
typedef GAS unsigned gu32;
typedef GAS unsigned long long gu64;
#define RLX_AGENT __ATOMIC_RELAXED, __HIP_MEMORY_SCOPE_AGENT
#define LDS_WAIT() asm volatile("s_waitcnt lgkmcnt(0)" ::: "memory")
#define VM_WAIT() asm volatile("s_waitcnt vmcnt(0)" ::: "memory")
__device__ __forceinline__ unsigned long long rt() { return __builtin_amdgcn_s_memrealtime(); }
__device__ __forceinline__ unsigned f2bf(float f) { unsigned u = __builtin_bit_cast(unsigned, f); return (u + 0x7fffu + ((u >> 16) & 1u)) >> 16; }
__device__ __forceinline__ unsigned pk2(float lo, float hi) { return f2bf(lo) | (f2bf(hi) << 16); }

#define XB_TMO      128
#define XB_XCNT(j)  (256  + 64 * (j))
#define XB_XSUB(j)  (1280 + 64 * (j))
#define XB_XGEN(j)  (2304 + 64 * (j))
#define XB_TOP      3328
#define XB_TOPGEN   3392
#define XCD_BAR_WORDS 3456
#define XB_SPIN_CAP (1u << 18)

__device__ __forceinline__ unsigned xb_ld(unsigned* p)              { return __hip_atomic_load(p, __ATOMIC_RELAXED, __HIP_MEMORY_SCOPE_AGENT); }
__device__ __forceinline__ unsigned xb_add(unsigned* p, unsigned v) { return __hip_atomic_fetch_add(p, v, __ATOMIC_RELAXED, __HIP_MEMORY_SCOPE_AGENT); }
__device__ __forceinline__ unsigned xb_xcc_id() { return (unsigned)__builtin_amdgcn_s_getreg((3 << 11) | 20) & 0xFu; }
#define XB_SPIN(cond, bar) do { unsigned _sp = 0; while (cond) { __builtin_amdgcn_s_sleep(1); \
    if ((++_sp & 255u) == 0u) { if (xb_ld(&(bar)[XB_TMO])) break; if (_sp > XB_SPIN_CAP) { atomicAdd(&(bar)[XB_TMO], 1u); break; } } } } while (0)

struct XcdBarrier {
    unsigned* bar; unsigned x;
    volatile LAS unsigned* st;
};

__device__ __forceinline__ XcdBarrier xcd_barrier_post(unsigned* bar, volatile LAS unsigned* st) {
    XcdBarrier b; b.bar = bar; b.x = xb_xcc_id(); b.st = st;
    if (threadIdx.x == 0) (void)xb_add(&bar[XB_XCNT(b.x)], 1u);
    return b;
}
__device__ __forceinline__ void xcd_barrier_complete(unsigned* bar, unsigned x, unsigned& nloc, unsigned& nx) {
    const unsigned G = gridDim.x * gridDim.y * gridDim.z;
    unsigned sum, cnt, mine, sp = 0u;
    for (;;) {
        sum = 0u; cnt = 0u; mine = 0u;
#pragma unroll
        for (unsigned j = 0; j < 16; ++j) { const unsigned c = xb_ld(&bar[XB_XCNT(j)]); sum += c; cnt += (c > 0u) ? 1u : 0u; mine = (j == x) ? c : mine; }
        if (sum == G) break;
        __builtin_amdgcn_s_sleep(1);
        if ((++sp & 255u) == 0u) { if (xb_ld(&bar[XB_TMO])) break; if (sp > XB_SPIN_CAP) { atomicAdd(&bar[XB_TMO], 1u); break; } }
    }
    nloc = mine > 0u ? mine : 1u; nx = cnt > 0u ? cnt : 1u;
}

__device__ __forceinline__ void xcd_barrier(const XcdBarrier& b) {
    asm volatile("s_waitcnt vmcnt(0)" ::: "memory");
    __syncthreads();
    if (threadIdx.x == 0) {
        unsigned* bar = b.bar;
        __builtin_amdgcn_s_waitcnt(0);
        unsigned nloc = b.st[0], nx = b.st[1];
        if (nloc == 0u) { xcd_barrier_complete(bar, b.x, nloc, nx); b.st[0] = nloc; b.st[1] = nx; }
        const unsigned old = xb_add(&bar[XB_XSUB(b.x)], 1u);
        const unsigned gen = old / nloc;
        if (old + 1u == (gen + 1u) * nloc) {
            __builtin_amdgcn_fence(__ATOMIC_RELEASE, "agent");
            asm volatile("s_waitcnt vmcnt(0)" ::: "memory");
            const unsigned og = xb_add(&bar[XB_TOP], 1u);
            const unsigned tg = og / nx;
            if (og + 1u == (tg + 1u) * nx) xb_add(&bar[XB_TOPGEN], 1u);
            else XB_SPIN(xb_ld(&bar[XB_TOPGEN]) == tg, bar);
            __builtin_amdgcn_fence(__ATOMIC_ACQUIRE, "agent");
            xb_add(&bar[XB_XGEN(b.x)], 1u);
            asm volatile("s_waitcnt vmcnt(0)" ::: "memory");
        } else {
            XB_SPIN(xb_ld(&bar[XB_XGEN(b.x)]) == gen, bar);
            __builtin_amdgcn_fence(__ATOMIC_ACQUIRE, "agent");
            asm volatile("s_waitcnt vmcnt(0)" ::: "memory");
        }
    }
    __syncthreads();
}


constexpr int NWAVES = 8;
#ifndef MK_N_LAUNCHES
#define MK_N_LAUNCHES 1
#endif
constexpr int N_PHASES = 10;
constexpr int N_LAUNCHES = MK_N_LAUNCHES;
static_assert(N_LAUNCHES == 1 || N_LAUNCHES == N_PHASES, "MK_N_LAUNCHES is 1 or 10");
#ifndef MK_REPEAT_PHASE
#define MK_REPEAT_PHASE (-1)
#endif

constexpr int DM = 1024, BP = 8, TP = 8192, BS = 8, TSQ = 64, MP = BP * TP, MS = BS * TSQ, M = MP + MS;
constexpr int DIN = 7168, FF = 4096, NH = 8, HD = 128, CROWS = 512, NCHUNK = TP / 64;
constexpr float LN_EPS = 1e-5f, ALPHA = 1.189207115002721f;
static_assert(M % 256 == 0, "row tiles");
enum { ZXR = 0, ZGL = 1, ZQ = 2, ZK = 3, ZV = 4, ZGA = 5, ZGB = 6 };
constexpr int MOD_SH1 = 0, MOD_SC1 = 1024, MOD_G1 = 2048, MOD_SH2 = 3072, MOD_SC2 = 4096, MOD_G2 = 5120;

constexpr size_t MiB = 1u << 20;
constexpr size_t WS_CTL = 0, CTL_ZERO_BYTES = 1 * MiB;
constexpr size_t WS_MOD = 1 * MiB;
constexpr size_t WS_WIN = 2 * MiB, WS_WOUT = 16 * MiB, WS_WUP = 18 * MiB, WS_WDN = 26 * MiB, WS_WRG = 34 * MiB, WS_WIG = 34 * MiB + 256 * 1024;
constexpr size_t WS_CK = 35 * MiB, WS_CV = 43 * MiB;
constexpr size_t WS_AGG = 51 * MiB;
constexpr size_t WS_Z = 64 * MiB, ZBUF = (size_t)M * 1024 * 2;
constexpr size_t WS_END = WS_Z + 7 * ZBUF;
constexpr size_t WS_MERGED = WS_Z, WS_U2 = WS_Z, WS_X1 = WS_Z + ZBUF, WS_H = WS_Z + 3 * ZBUF;
constexpr size_t OUT_YP = 0, OUT_YS = 67108864, OUT_KP = 67633152, OUT_VP = 71827456, OUT_CP = 76021760, OUT_HP = 76046336, OUT_KS = 76054528, OUT_VS = 76578816, OUT_CS = 77103104, OUT_HS = 77127680, OUT_TOTAL = 77135872;
constexpr int CW_TMO = 0, CW_CODE = 1, CW_BAR = 4096;

constexpr int RING_OFF = 0, RING_BYTES = 131072;
constexpr int SCRATCH_BYTES = 155648;
constexpr int LDSCTL_OFF = SCRATCH_BYTES, MISC_OFF = LDSCTL_OFF + 320;
constexpr int LDS_BYTES = 163840;
static_assert(MISC_OFF + 128 <= LDS_BYTES, "LDS map");
constexpr int LW_RG = 0, LW_IG = 32768, L_XR = 65536, L_XC = 82944, L_G = 99328, L_Y1 = 115712, L_AGG = 132096, L_CAR = 136192;
static_assert(L_CAR + 1024 <= SCRATCH_BYTES && attn::ATTN_LDS <= SCRATCH_BYTES, "LDS scratch");


struct Frame {
    LAS unsigned char* lds;
    volatile LAS unsigned* MISC;
    gu32* ctl;
    int tid, lane, wave;
    int vcu, G;
    const float *x_p, *x_s, *c_p, *c_s, *cache_k, *cache_v, *state_conv, *state_lru, *w_ada, *b_ada, *w_in, *conv_w, *conv_b, *w_rg, *b_rg, *w_ig, *b_ig, *lam, *rel_bias,
                *w_out, *ln1_g, *ln1_b, *w_up, *b_up, *w_down, *b_down, *ln2_g, *ln2_b;
    float* out; unsigned char* ws;
    float* mod; float* agg;
    bf16 *Win_t, *Wout_t, *Wup_t, *Wdn_t, *Wrg_t, *Wig_t, *CK, *CV, *Z;
};
__device__ __forceinline__ bf16* zbuf(Frame& F, int i) { return (bf16*)(F.ws + WS_Z + (size_t)i * ZBUF); }
__device__ __forceinline__ float sigmoid_f(float x) { return __builtin_amdgcn_rcpf(1.f + __builtin_amdgcn_exp2f(-1.4426950408889634f * x)); }
__device__ __forceinline__ float gelu_tanh_f(float x) { const float y = 0.7978845608028654f * (x + 0.044715f * x * x * x); return x * sigmoid_f(2.f * y); }
__device__ __forceinline__ float bf2f(unsigned short v) { return __uint_as_float(((unsigned)v) << 16); }
__device__ __forceinline__ int batch_of_row(int row) { return row < MP ? (row >> 13) : 8 + ((row - MP) >> 6); }

__device__ __forceinline__ float wave_sum(float v) {
#pragma unroll
    for (int o = 1; o < 64; o <<= 1) v += __shfl_xor(v, o);
    return v;
}
__device__ __forceinline__ void p0_transpose_item(const float* W, int K, int N, bf16* WT, int row_off, LAS float* scr, int item, int lane) {
    const int nblk = N / 32, kb = item / nblk, nb = item % nblk, k0 = 64 * kb, n0 = 32 * nb;
#pragma unroll 8
    for (int i = 0; i < 32; ++i) { const int kk = 2 * i + (lane >> 5); scr[kk * 33 + (lane & 31)] = W[(size_t)(k0 + kk) * N + n0 + (lane & 31)]; }
    LDS_WAIT(); asm volatile("" ::: "memory");
    const int c = lane & 7;
#pragma unroll
    for (int j = 0; j < 4; ++j) { const int n = (lane >> 3) + 8 * j; const LAS float* s = scr + (8 * c) * 33 + n;
        v4u o; o.x = pk2(s[0 * 33], s[1 * 33]); o.y = pk2(s[2 * 33], s[3 * 33]); o.z = pk2(s[4 * 33], s[5 * 33]); o.w = pk2(s[6 * 33], s[7 * 33]);
        *(GAS v4u*)(WT + (size_t)(row_off + n0 + n) * K + k0 + 8 * c) = o; }
    LDS_WAIT(); asm volatile("" ::: "memory");
}
__device__ __forceinline__ void p0_mod_item(Frame& F, const LAS float* sl, int it) {
    const int cb = it >> 2, bq = it & 3, kq = F.lane >> 4, cq = F.lane & 15, col = 64 * cb + 4 * cq;
    f32x4 acc[4];
#pragma unroll
    for (int bb = 0; bb < 4; ++bb) acc[bb] = (f32x4){0.f, 0.f, 0.f, 0.f};
    const float* wp = F.w_ada + (size_t)(256 * kq) * 6144 + col;
    const LAS float* sp = sl + (4 * bq) * 1024 + 256 * kq;
#pragma unroll 2
    for (int kk = 0; kk < 256; kk += 4) {
        f32x4 s[4];
#pragma unroll
        for (int bb = 0; bb < 4; ++bb) s[bb] = *(const LAS f32x4*)(sp + bb * 1024 + kk);
#pragma unroll
        for (int i = 0; i < 4; ++i) { const f32x4 w = *(const f32x4*)(wp + (size_t)(kk + i) * 6144);
#pragma unroll
            for (int bb = 0; bb < 4; ++bb) acc[bb] += w * s[bb][i]; }
    }
#pragma unroll
    for (int bb = 0; bb < 4; ++bb)
#pragma unroll
        for (int e = 0; e < 4; ++e) { float v = acc[bb][e]; v += __shfl_xor(v, 16); v += __shfl_xor(v, 32); acc[bb][e] = v; }
    if (kq == 0) { const f32x4 bv = *(const f32x4*)(F.b_ada + col);
#pragma unroll
        for (int bb = 0; bb < 4; ++bb) *(f32x4*)(F.mod + (size_t)(4 * bq + bb) * 6144 + col) = acc[bb] + bv; }
}
__device__ __forceinline__ void p0_prologue(Frame& F) {
    LAS float* sl = (LAS float*)F.lds;
    for (int i = F.tid; i < 16 * 1024; i += NWAVES * 64) { const float c = i < 8192 ? F.c_p[i] : F.c_s[i - 8192]; sl[i] = c / (1.f + __expf(-c)); }
    __syncthreads();
    LAS float* scr = (LAS float*)(F.lds + 65536 + F.wave * 8448);
    const int gw = F.vcu * NWAVES + F.wave, NGW = F.G * NWAVES;
    constexpr int I_MOD = 384, I_IN = (DM / 64) * (DIN / 32), I_OUT = (DM / 64) * (DM / 32), I_UP = (DM / 64) * (FF / 32), I_DN = (FF / 64) * (DM / 32), I_G = 8 * 8;
    constexpr int NITEMS = I_MOD + I_IN + I_OUT + I_UP + I_DN + 2 * I_G;
    for (int it = gw; it < NITEMS; it += NGW) {
        int r = it;
        if (r < I_MOD) { p0_mod_item(F, sl, r); continue; } r -= I_MOD;
        if (r < I_IN) { p0_transpose_item(F.w_in, DM, DIN, F.Win_t, 0, scr, r, F.lane); continue; } r -= I_IN;
        if (r < I_OUT) { p0_transpose_item(F.w_out, DM, DM, F.Wout_t, 0, scr, r, F.lane); continue; } r -= I_OUT;
        if (r < I_UP) { p0_transpose_item(F.w_up, DM, FF, F.Wup_t, 0, scr, r, F.lane); continue; } r -= I_UP;
        if (r < I_DN) { p0_transpose_item(F.w_down, FF, DM, F.Wdn_t, 0, scr, r, F.lane); continue; } r -= I_DN;
        if (r < I_G) { const int n = r >> 3; p0_transpose_item(F.w_rg + (size_t)n * 16384, 128, 128, F.Wrg_t + (size_t)n * 16384, 0, scr, r & 7, F.lane); continue; } r -= I_G;
        { const int n = r >> 3; p0_transpose_item(F.w_ig + (size_t)n * 16384, 128, 128, F.Wig_t + (size_t)n * 16384, 0, scr, r & 7, F.lane); }
    }
    constexpr int NC8 = 4194304 / 8;
    for (int i = gw * 64 + F.lane; i < 2 * NC8; i += NGW * 64) {
        const bool isk = i < NC8; const int j = isk ? i : i - NC8;
        const float* src = (isk ? F.cache_k : F.cache_v) + (size_t)j * 8;
        const f32x4 a = *(const f32x4*)src, b = *(const f32x4*)(src + 4);
        v4u o; o.x = pk2(a.x, a.y); o.y = pk2(a.z, a.w); o.z = pk2(b.x, b.y); o.w = pk2(b.z, b.w);
        *(GAS v4u*)((isk ? F.CK : F.CV) + (size_t)j * 8) = o;
    }
}
__device__ __forceinline__ void p1_upass(Frame& F, bf16* U) {
    const int gw = F.vcu * NWAVES + F.wave, NGW = F.G * NWAVES;
    for (int m = gw; m < M; m += NGW) {
        const float* xr = m < MP ? F.x_p + (size_t)m * 1024 : F.x_s + (size_t)(m - MP) * 1024;
        const float* md = F.mod + (size_t)batch_of_row(m) * 6144;
        GAS unsigned long long* o8 = (GAS unsigned long long*)(U + (size_t)m * 1024) + F.lane;
#pragma unroll
        for (int j = 0; j < 4; ++j) { const int idx = 4 * F.lane + 256 * j;
            const f32x4 x = *(const f32x4*)(xr + idx), sh = *(const f32x4*)(md + MOD_SH1 + idx), sc = *(const f32x4*)(md + MOD_SC1 + idx);
            const f32x4 u = x * (sc + 1.0f) + sh;
            o8[64 * j] = (unsigned long long)pk2(u.x, u.y) | ((unsigned long long)pk2(u.z, u.w) << 32); }
    }
}
template <bool FIRST> __device__ __forceinline__ void ln_pass(Frame& F, const float* R, float* X1, bf16* U2, const float* g, const float* bta) {
    const int gw = F.vcu * NWAVES + F.wave, NGW = F.G * NWAVES;
    for (int m = gw; m < M; m += NGW) {
        const float* rr = R + (size_t)m * 1024;
        f32x4 v[4]; float s = 0.f;
#pragma unroll
        for (int j = 0; j < 4; ++j) { v[j] = *(const f32x4*)(rr + 4 * F.lane + 256 * j); s += (v[j].x + v[j].y) + (v[j].z + v[j].w); }
        const float mean = wave_sum(s) * (1.f / 1024.f); float s2 = 0.f;
#pragma unroll
        for (int j = 0; j < 4; ++j) { v[j] = v[j] - mean; s2 += (v[j].x * v[j].x + v[j].y * v[j].y) + (v[j].z * v[j].z + v[j].w * v[j].w); }
        const float rstd = 1.f / sqrtf(wave_sum(s2) * (1.f / 1024.f) + LN_EPS);
        const float* md = F.mod + (size_t)batch_of_row(m) * 6144;
#pragma unroll
        for (int j = 0; j < 4; ++j) { const int idx = 4 * F.lane + 256 * j;
            const f32x4 y = v[j] * rstd * *(const f32x4*)(g + idx) + *(const f32x4*)(bta + idx);
            *(f32x4*)(X1 + (size_t)m * 1024 + idx) = y;
            if (FIRST) { const f32x4 sh = *(const f32x4*)(md + MOD_SH2 + idx), sc = *(const f32x4*)(md + MOD_SC2 + idx); const f32x4 u = y * (sc + 1.0f) + sh;
                *((GAS unsigned long long*)(U2 + (size_t)m * 1024 + idx)) = (unsigned long long)pk2(u.x, u.y) | ((unsigned long long)pk2(u.z, u.w) << 32); } }
    }
}
#define LSWZ(row, colB) ((row) * 256 + ((colB) ^ (((row) & 7) << 4)))
__device__ __forceinline__ v4u g_tile8(const v4u gl, const v4u ga) {
    float g[8];
    const unsigned lw[4] = {gl.x, gl.y, gl.z, gl.w}, aw[4] = {ga.x, ga.y, ga.z, ga.w};
#pragma unroll
    for (int e = 0; e < 4; ++e) { g[2 * e] = gelu_tanh_f(__uint_as_float(lw[e] << 16)) * sigmoid_f(__uint_as_float(aw[e] << 16));
        g[2 * e + 1] = gelu_tanh_f(__uint_as_float(lw[e] & 0xffff0000u)) * sigmoid_f(__uint_as_float(aw[e] & 0xffff0000u)); }
    v4u o; o.x = pk2(g[0], g[1]); o.y = pk2(g[2], g[3]); o.z = pk2(g[4], g[5]); o.w = pk2(g[6], g[7]); return o;
}
__device__ __forceinline__ void p3_lru(Frame& F, bf16* Y0, bf16* Y1) {
    LAS unsigned char* L = F.lds;
    const int pair = F.vcu >> 2, quarter = F.vcu & 3, b = pair >> 3, n = pair & 7;
    const bf16* XR = zbuf(F, ZXR); const bf16* GL = zbuf(F, ZGL); const bf16* GA = zbuf(F, ZGA);
    for (int idx = F.tid; idx < 2 * 2048; idx += NWAVES * 64) { const int g = idx >> 11, r = (idx >> 4) & 127, ch = idx & 15;
        const bf16* src = (g ? F.Wig_t : F.Wrg_t) + ((size_t)(n * 128 + r)) * 128 + ch * 8;
        *(LAS v4u*)(L + (g ? LW_IG : LW_RG) + LSWZ(r, ch * 16)) = *(const v4u*)src; }
    const int w = F.wave, rb = w & 3, chf = w >> 2, fr = F.lane & 15, fq = F.lane >> 4;
    const int st = F.tid >> 3, scg = F.tid & 7, scl = scg * 16, sch = n * 128 + scl;
    float brg[4], big[4], c8[4];
#pragma unroll
    for (int cb = 0; cb < 4; ++cb) { const int dch = n * 128 + 64 * chf + 16 * cb + fr; brg[cb] = F.b_rg[dch]; big[cb] = F.b_ig[dch]; c8[cb] = -8.0f * log1pf(__expf(-F.lam[dch])) * 1.4426950408889634f; }
    LAS float* carry = (LAS float*)(L + L_CAR);
    LAS float* aggl = (LAS float*)(L + L_AGG);
    if (F.tid < 128) { carry[2 * F.tid] = 1.f; carry[2 * F.tid + 1] = 0.f; }
    const int nitems = 32 + (quarter == 0 ? 1 : 0);
    v4u xr0, xr1, gl0, gl1, ga0, ga1, xp0, xp1;
#define ITEM_ROW0(it) ((it) < 32 ? (size_t)b * TP + (size_t)(32 * quarter + (it)) * 64 : (size_t)MP + (size_t)b * 64)
#define STAGE_LOAD(it) do { const size_t gi_ = (ITEM_ROW0(it) + st) * 1024 + sch; xr0 = *(const v4u*)(XR + gi_); xr1 = *(const v4u*)(XR + gi_ + 8); \
        gl0 = *(const v4u*)(GL + gi_); gl1 = *(const v4u*)(GL + gi_ + 8); ga0 = *(const v4u*)(GA + gi_); ga1 = *(const v4u*)(GA + gi_ + 8); } while (0)
#define STAGE_WRITE(it) do { \
        *(LAS v4u*)(L + L_XR + LSWZ(3 + st, scl * 2)) = xr0; *(LAS v4u*)(L + L_XR + LSWZ(3 + st, scl * 2 + 16)) = xr1; \
        *(LAS v4u*)(L + L_G + st * 256 + scl * 2) = g_tile8(gl0, ga0); *(LAS v4u*)(L + L_G + st * 256 + scl * 2 + 16) = g_tile8(gl1, ga1); \
        if (st >= 61) { v4u h0_, h1_; \
            if ((it) == 32) { const float* sp_ = F.state_conv + ((size_t)b * 3 + (st - 61)) * 1024 + sch; const f32x4 a_ = *(const f32x4*)sp_, b_ = *(const f32x4*)(sp_ + 4), c_ = *(const f32x4*)(sp_ + 8), d_ = *(const f32x4*)(sp_ + 12); \
                h0_.x = pk2(a_.x, a_.y); h0_.y = pk2(a_.z, a_.w); h0_.z = pk2(b_.x, b_.y); h0_.w = pk2(b_.z, b_.w); h1_.x = pk2(c_.x, c_.y); h1_.y = pk2(c_.z, c_.w); h1_.z = pk2(d_.x, d_.y); h1_.w = pk2(d_.z, d_.w); } \
            else if ((it) > 0) { h0_ = xp0; h1_ = xp1; } \
            else if (quarter == 0) { h0_ = (v4u){0u, 0u, 0u, 0u}; h1_ = h0_; } \
            else { const size_t gp_ = (ITEM_ROW0(0) - 64 + st) * 1024 + sch; h0_ = *(const v4u*)(XR + gp_); h1_ = *(const v4u*)(XR + gp_ + 8); } \
            *(LAS v4u*)(L + L_XR + LSWZ(st - 61, scl * 2)) = h0_; *(LAS v4u*)(L + L_XR + LSWZ(st - 61, scl * 2 + 16)) = h1_; \
            if ((it) == 32 || (quarter == 3 && (it) == 31)) { float* oc_ = F.out + ((it) == 32 ? OUT_CS : OUT_CP) + ((size_t)b * 3 + (st - 61)) * 1024 + sch; \
                const unsigned xw_[8] = {xr0.x, xr0.y, xr0.z, xr0.w, xr1.x, xr1.y, xr1.z, xr1.w}; \
                _Pragma("unroll") for (int e_ = 0; e_ < 4; ++e_) *(f32x4*)(oc_ + 4 * e_) = (f32x4){__uint_as_float(xw_[2 * e_] << 16), __uint_as_float(xw_[2 * e_] & 0xffff0000u), __uint_as_float(xw_[2 * e_ + 1] << 16), __uint_as_float(xw_[2 * e_ + 1] & 0xffff0000u)}; } } \
        xp0 = xr0; xp1 = xr1; } while (0)
    STAGE_LOAD(0);
    STAGE_WRITE(0);
    __syncthreads();
    for (int it = 0; it < nitems; ++it) {
        const bool smp = it == 32; const size_t row0 = ITEM_ROW0(it);
        if (smp) {
            if (F.tid < 128) { float* ao = F.agg + ((size_t)(b * 8 + n) * 4 + quarter) * 256; ao[F.tid] = carry[2 * F.tid]; ao[128 + F.tid] = carry[2 * F.tid + 1];
                carry[2 * F.tid] = 1.f; carry[2 * F.tid + 1] = F.state_lru[(size_t)b * 1024 + n * 128 + F.tid]; }
            __syncthreads(); }
        if (it + 1 < nitems) STAGE_LOAD(it + 1);
#pragma unroll
        for (int half = 0; half < 2; ++half) { const int cl = scl + 8 * half, ch = n * 128 + cl;
            float xc[8];
            { const f32x4 c0 = *(const f32x4*)(F.conv_b + ch), c1 = *(const f32x4*)(F.conv_b + ch + 4); xc[0] = c0.x; xc[1] = c0.y; xc[2] = c0.z; xc[3] = c0.w; xc[4] = c1.x; xc[5] = c1.y; xc[6] = c1.z; xc[7] = c1.w; }
#pragma unroll
            for (int k = 0; k < 4; ++k) { const v4u raw = *(const LAS v4u*)(L + L_XR + LSWZ(st + k, cl * 2));
                const f32x4 w0 = *(const f32x4*)(F.conv_w + (size_t)k * 1024 + ch), w1 = *(const f32x4*)(F.conv_w + (size_t)k * 1024 + ch + 4);
                xc[0] = fmaf(__uint_as_float(raw.x << 16), w0.x, xc[0]); xc[1] = fmaf(__uint_as_float(raw.x & 0xffff0000u), w0.y, xc[1]);
                xc[2] = fmaf(__uint_as_float(raw.y << 16), w0.z, xc[2]); xc[3] = fmaf(__uint_as_float(raw.y & 0xffff0000u), w0.w, xc[3]);
                xc[4] = fmaf(__uint_as_float(raw.z << 16), w1.x, xc[4]); xc[5] = fmaf(__uint_as_float(raw.z & 0xffff0000u), w1.y, xc[5]);
                xc[6] = fmaf(__uint_as_float(raw.w << 16), w1.z, xc[6]); xc[7] = fmaf(__uint_as_float(raw.w & 0xffff0000u), w1.w, xc[7]); }
            v4u o; o.x = pk2(xc[0], xc[1]); o.y = pk2(xc[2], xc[3]); o.z = pk2(xc[4], xc[5]); o.w = pk2(xc[6], xc[7]);
            *(LAS v4u*)(L + L_XC + LSWZ(st, cl * 2)) = o; }
        __syncthreads();
        float Pl[4][4], hl[4][4], ep[4], eh[4];
        { f32x4 acc[2][4];
#pragma unroll
          for (int g = 0; g < 2; ++g)
#pragma unroll
            for (int cb = 0; cb < 4; ++cb) acc[g][cb] = (f32x4){0.f, 0.f, 0.f, 0.f};
#pragma unroll
          for (int ks = 0; ks < 4; ++ks) { const int kb = (32 * ks + 8 * fq) * 2;
            const bf16x8 A = *(const LAS bf16x8*)(L + L_XC + LSWZ(16 * rb + fr, kb));
#pragma unroll
            for (int cb = 0; cb < 4; ++cb) { const int d = 64 * chf + 16 * cb + fr;
                const bf16x8 Br = *(const LAS bf16x8*)(L + LW_RG + LSWZ(d, kb)), Bi = *(const LAS bf16x8*)(L + LW_IG + LSWZ(d, kb));
                acc[0][cb] = __builtin_amdgcn_mfma_f32_16x16x32_bf16(A, Br, acc[0][cb], 0, 0, 0);
                acc[1][cb] = __builtin_amdgcn_mfma_f32_16x16x32_bf16(A, Bi, acc[1][cb], 0, 0, 0); } }
          const bool reset = (quarter == 0 && it == 0 && rb == 0 && fq == 0);
#pragma unroll
          for (int cb = 0; cb < 4; ++cb) { const int dl = 64 * chf + 16 * cb + fr;
            float P = 1.f, h = 0.f;
#pragma unroll
            for (int rg = 0; rg < 4; ++rg) { const int t = 16 * rb + 4 * fq + rg;
                const float r = sigmoid_f(acc[0][cb][rg] + brg[cb]), ig = sigmoid_f(acc[1][cb][rg] + big[cb]);
                float a = __builtin_amdgcn_exp2f(c8[cb] * r); float mult = __builtin_amdgcn_sqrtf(fmaxf(1.f - a * a, 0.f));
                if (reset && rg == 0) { a = 0.f; mult = 1.f; }
                const float xcv = bf2f(*(const LAS unsigned short*)(L + L_XC + LSWZ(t, dl * 2)));
                h = fmaf(a, h, mult * ig * xcv); P = a * P; Pl[cb][rg] = P; hl[cb][rg] = h; }
            float Pg = P, Hg = h;
            { const float up = __shfl_up(Pg, 16), uh = __shfl_up(Hg, 16); if (fq >= 1) { Hg = fmaf(Pg, uh, Hg); Pg = Pg * up; } }
            { const float up = __shfl_up(Pg, 32), uh = __shfl_up(Hg, 32); if (fq >= 2) { Hg = fmaf(Pg, uh, Hg); Pg = Pg * up; } }
            { const float up = __shfl_up(Pg, 16), uh = __shfl_up(Hg, 16); ep[cb] = fq == 0 ? 1.f : up; eh[cb] = fq == 0 ? 0.f : uh; }
            if (fq == 3) { aggl[(rb * 128 + dl) * 2] = Pg; aggl[(rb * 128 + dl) * 2 + 1] = Hg; } }
        }
        __syncthreads();
        float ncP[4], nch[4];
#pragma unroll
        for (int cb = 0; cb < 4; ++cb) { const int dl = 64 * chf + 16 * cb + fr;
            float Pin = carry[2 * dl], Hin = carry[2 * dl + 1];
            for (int q2 = 0; q2 < rb; ++q2) { const float Pq = aggl[(q2 * 128 + dl) * 2], Hq = aggl[(q2 * 128 + dl) * 2 + 1]; Hin = fmaf(Pq, Hin, Hq); Pin = Pq * Pin; }
            const float Hs = fmaf(ep[cb], Hin, eh[cb]), Ps = ep[cb] * Pin;
#pragma unroll
            for (int rg = 0; rg < 4; ++rg) { const int t = 16 * rb + 4 * fq + rg;
                const float hh = fmaf(Pl[cb][rg], Hs, hl[cb][rg]), PP = Pl[cb][rg] * Ps;
                const float G = bf2f(*(const LAS unsigned short*)(L + L_G + t * 256 + dl * 2));
                *(LAS unsigned short*)(L + L_XC + t * 256 + dl * 2) = (unsigned short)f2bf(hh * G);
                *(LAS unsigned short*)(L + L_Y1 + t * 256 + dl * 2) = (unsigned short)f2bf(PP * G);
                if (rg == 3) { ncP[cb] = PP; nch[cb] = hh; } } }
        __syncthreads();
        if (rb == 3 && fq == 3) {
#pragma unroll
            for (int cb = 0; cb < 4; ++cb) { const int dl = 64 * chf + 16 * cb + fr; carry[2 * dl] = ncP[cb]; carry[2 * dl + 1] = nch[cb]; } }
        { const size_t go = (row0 + st) * 1024 + sch;
          const v4u a0 = *(const LAS v4u*)(L + L_XC + st * 256 + scl * 2), a1 = *(const LAS v4u*)(L + L_XC + st * 256 + scl * 2 + 16);
          const v4u b0 = *(const LAS v4u*)(L + L_Y1 + st * 256 + scl * 2), b1 = *(const LAS v4u*)(L + L_Y1 + st * 256 + scl * 2 + 16);
          *(GAS v4u*)(Y0 + go) = a0; *(GAS v4u*)(Y0 + go + 8) = a1; *(GAS v4u*)(Y1 + go) = b0; *(GAS v4u*)(Y1 + go + 8) = b1; }
        if (it + 1 < nitems) STAGE_WRITE(it + 1);
        __syncthreads();
    }
    if (F.tid < 128) {
        if (quarter == 0) F.out[OUT_HS + (size_t)b * 1024 + n * 128 + F.tid] = carry[2 * F.tid + 1];
        else { float* ao = F.agg + ((size_t)(b * 8 + n) * 4 + quarter) * 256; ao[F.tid] = carry[2 * F.tid]; ao[128 + F.tid] = carry[2 * F.tid + 1]; } }
#undef ITEM_ROW0
#undef STAGE_LOAD
#undef STAGE_WRITE
    { const int gw = F.vcu * NWAVES + F.wave, NGW = F.G * NWAVES;
      const bf16* ZKb = zbuf(F, ZK); const bf16* ZVb = zbuf(F, ZV);
      for (int r = gw; r < 9216; r += NGW) {
          const bf16* src; float* dst;
          if (r < 8192) { const int isv = r >> 12, rr = r & 4095, bb = rr >> 9, k = rr & 511; src = (isv ? ZVb : ZKb) + ((size_t)bb * TP + (TP - CROWS) + k) * 1024; dst = F.out + (isv ? OUT_VP : OUT_KP) + (size_t)rr * 1024; }
          else { const int r2 = r - 8192, isv = r2 >> 9, rr = r2 & 511; src = (isv ? ZVb : ZKb) + ((size_t)MP + rr) * 1024; dst = F.out + (isv ? OUT_VS : OUT_KS) + (size_t)rr * 1024; }
#pragma unroll
          for (int hf = 0; hf < 2; ++hf) { const v4u raw = *(const v4u*)(src + hf * 512 + F.lane * 8); float* d = dst + hf * 512 + F.lane * 8;
              *(f32x4*)d = (f32x4){__uint_as_float(raw.x << 16), __uint_as_float(raw.x & 0xffff0000u), __uint_as_float(raw.y << 16), __uint_as_float(raw.y & 0xffff0000u)};
              *(f32x4*)(d + 4) = (f32x4){__uint_as_float(raw.z << 16), __uint_as_float(raw.z & 0xffff0000u), __uint_as_float(raw.w << 16), __uint_as_float(raw.w & 0xffff0000u)}; }
      } }
}
__device__ __forceinline__ attn::AUnit p4_unit(Frame& F, int b, int h, int quarter, int ui, size_t& row0) {
    const long offK = (long)((WS_Z + (size_t)ZK * ZBUF) / 2), offV = (long)((WS_Z + (size_t)ZV * ZBUF) / 2), offCK = (long)(WS_CK / 2), offCV = (long)(WS_CV / 2);
    attn::AUnit u; u.wsb = (const bf16*)F.ws; const int g = 8 * quarter + ui;
    if (ui < 8) { row0 = (size_t)b * TP + 256 * g;
        u.kA = offK + ((long)b * TP + (long)(4 * g - 8) * 64) * 1024 + h * 128; u.vA = offV + ((long)b * TP + (long)(4 * g - 8) * 64) * 1024 + h * 128;
        u.kB = u.kA; u.vB = u.vA; u.tsw = 1 << 30; u.t0 = (8 - 4 * g) > 0 ? (8 - 4 * g) : 0; u.nt = 12; u.nwq = 8; }
    else { row0 = (size_t)MP + b * 64;
        u.kA = offCK + ((long)b * CROWS) * 1024 + h * 128; u.vA = offCV + ((long)b * CROWS) * 1024 + h * 128;
        u.kB = offK + ((long)MP + b * 64) * 1024 + h * 128; u.vB = offV + ((long)MP + b * 64) * 1024 + h * 128; u.tsw = 8; u.t0 = 0; u.nt = 10; u.nwq = 2; }
    u.q = zbuf(F, ZQ) + row0 * 1024 + h * 128;
    return u;
}
__device__ __forceinline__ void p4_attention(Frame& F, const bf16* Y0, const bf16* Y1, bf16* MG) {
    char* lds = (char*)F.lds;
    const int pair = F.vcu >> 2, quarter = F.vcu & 3, b = pair >> 3, h = pair & 7;
    const int wid = F.wave, lane = F.lane, r32 = lane & 31, hi = lane >> 5, ech = lane & 15, err = lane >> 4;
    const float* ag = F.agg + ((size_t)(b * 8 + h) * 4) * 256;
    LAS float* hinv = (LAS float*)(F.lds + attn::L_HIN);
    { LAS float* tb = (LAS float*)(F.lds + attn::L_TB);
      for (int i = F.tid; i < 320; i += NWAVES * 64) tb[i] = F.rel_bias[h * 257 + (i < 256 ? i : 256)] * (1.0f / attn::SCALE);
      if (F.tid < 128) { float hv = 0.f; for (int c = 0; c < quarter; ++c) hv = fmaf(ag[c * 256 + F.tid], hv, ag[c * 256 + 128 + F.tid]); hinv[F.tid] = hv;
          if (quarter == 3) F.out[OUT_HP + (size_t)b * 1024 + h * 128 + F.tid] = fmaf(ag[3 * 256 + F.tid], hv, ag[3 * 256 + 128 + F.tid]); }
      __syncthreads(); }
    const bf16* ZGBb = zbuf(F, ZGB);
    const int nunits = 8 + (quarter == 0 ? 1 : 0);
    attn::SReg sr_[2];
    size_t row0; attn::AUnit u = p4_unit(F, b, h, quarter, 0, row0);
    attn::attn_prefetch(u, sr_);
    for (int ui = 0; ui < nunits; ++ui) {
        attn::f32x16 o[4]; float rli[16];
        attn::attn_unit(u, lds, sr_, o, rli);
        const int nwq = u.nwq; const size_t crow0 = row0; const bool smp = ui >= 8;
        if (ui + 1 < nunits) { u = p4_unit(F, b, h, quarter, ui + 1, row0); attn::attn_prefetch(u, sr_); }
        if (wid < nwq) {
            char* Ot = lds + wid * 8192;
            int hi_l = hi, ech_l = ech, err_l = err; asm volatile("" : "+v"(hi_l), "+v"(ech_l), "+v"(err_l));
#pragma unroll
            for (int r = 0; r < 16; ++r)
#pragma unroll
                for (int d0 = 0; d0 < 4; ++d0) *(unsigned short*)(Ot + attn::crow(r, hi_l) * 256 + (32 * d0 + r32) * 2) = (unsigned short)f2bf(o[d0][r] * rli[r]);
            asm volatile("s_waitcnt lgkmcnt(0)" ::: "memory");
            float hv[8];
            { const f32x4 a = *(const LAS f32x4*)(hinv + 8 * ech_l), c = *(const LAS f32x4*)(hinv + 8 * ech_l + 4); const float m = smp ? 0.f : 1.f;
              hv[0] = a.x * m; hv[1] = a.y * m; hv[2] = a.z * m; hv[3] = a.w * m; hv[4] = c.x * m; hv[5] = c.y * m; hv[6] = c.z * m; hv[7] = c.w * m; }
#pragma unroll
            for (int i = 0; i < 8; ++i) { const int row = 4 * i + err_l; const size_t gi = (crow0 + 32 * wid + row) * 1024 + h * 128 + ech_l * 8;
                const v4u ov = *(const v4u*)(Ot + row * 256 + ech_l * 16), y0 = *(const v4u*)(Y0 + gi), y1 = *(const v4u*)(Y1 + gi), gb = *(const v4u*)(ZGBb + gi);
                const unsigned ow[4] = {ov.x, ov.y, ov.z, ov.w}, y0w[4] = {y0.x, y0.y, y0.z, y0.w}, y1w[4] = {y1.x, y1.y, y1.z, y1.w}, gw_[4] = {gb.x, gb.y, gb.z, gb.w};
                unsigned rw[4];
#pragma unroll
                for (int e = 0; e < 4; ++e) {
                    const float lo = __uint_as_float(y0w[e] << 16) + __uint_as_float(y1w[e] << 16) * hv[2 * e] + sigmoid_f(__uint_as_float(gw_[e] << 16)) * __uint_as_float(ow[e] << 16);
                    const float hh = __uint_as_float(y0w[e] & 0xffff0000u) + __uint_as_float(y1w[e] & 0xffff0000u) * hv[2 * e + 1] + sigmoid_f(__uint_as_float(gw_[e] & 0xffff0000u)) * __uint_as_float(ow[e] & 0xffff0000u);
                    rw[e] = pk2(lo, hh); }
                *(GAS v4u*)(MG + gi) = (v4u){rw[0], rw[1], rw[2], rw[3]}; }
        }
        __syncthreads();
    }
}

struct Args { const float* in[28]; float* out; unsigned char* ws; int ph_lo, ph_hi, li, pad; };
__global__ void __launch_bounds__(NWAVES * 64, 2) mega_fwd(Args args) {
    extern __shared__ __attribute__((aligned(16))) unsigned char lds[];
    Frame F;
    F.lds = (LAS unsigned char*)lds;
    F.MISC = (volatile LAS unsigned*)(F.lds + MISC_OFF);
    F.tid = threadIdx.x; F.lane = F.tid & 63; F.wave = __builtin_amdgcn_readfirstlane(F.tid >> 6);
    F.G = gridDim.x; { const int bx = blockIdx.x; F.vcu = (F.G % 8 == 0) ? (bx % 8) * (F.G / 8) + bx / 8 : bx; }
    unsigned char* ws = args.ws; F.ws = ws; F.out = args.out;
    F.ctl = (gu32*)(ws + WS_CTL);
    F.x_p = args.in[0]; F.x_s = args.in[1]; F.c_p = args.in[2]; F.c_s = args.in[3]; F.cache_k = args.in[4]; F.cache_v = args.in[5]; F.state_conv = args.in[6]; F.state_lru = args.in[7];
    F.w_ada = args.in[8]; F.b_ada = args.in[9]; F.w_in = args.in[10]; F.conv_w = args.in[11]; F.conv_b = args.in[12]; F.w_rg = args.in[13]; F.b_rg = args.in[14]; F.w_ig = args.in[15]; F.b_ig = args.in[16];
    F.lam = args.in[17]; F.rel_bias = args.in[18]; F.w_out = args.in[19]; F.ln1_g = args.in[20]; F.ln1_b = args.in[21]; F.w_up = args.in[22]; F.b_up = args.in[23]; F.w_down = args.in[24]; F.b_down = args.in[25];
    F.ln2_g = args.in[26]; F.ln2_b = args.in[27];
    F.mod = (float*)(ws + WS_MOD); F.agg = (float*)(ws + WS_AGG);
    F.Win_t = (bf16*)(ws + WS_WIN); F.Wout_t = (bf16*)(ws + WS_WOUT); F.Wup_t = (bf16*)(ws + WS_WUP); F.Wdn_t = (bf16*)(ws + WS_WDN); F.Wrg_t = (bf16*)(ws + WS_WRG); F.Wig_t = (bf16*)(ws + WS_WIG);
    F.CK = (bf16*)(ws + WS_CK); F.CV = (bf16*)(ws + WS_CV); F.Z = (bf16*)(ws + WS_Z);
    for (int u = F.tid; u < (LDS_BYTES - LDSCTL_OFF) / 4; u += NWAVES * 64) ((LAS unsigned*)(F.lds + LDSCTL_OFF))[u] = 0u;
    __syncthreads();
    XcdBarrier bar; bar.bar = (unsigned*)(F.ctl + CW_BAR); bar.x = 0; bar.st = nullptr;
    if (N_LAUNCHES == 1) bar = xcd_barrier_post((unsigned*)(F.ctl + CW_BAR), F.MISC + 8);
#define GRID_BAR() do { if (N_LAUNCHES == 1) xcd_barrier(bar); } while (0)
    const int lo = args.ph_lo, hi = args.ph_hi;
#ifndef MK_PHASE_MASK
#define MK_PHASE_MASK 0x3ff
#endif
#define IN(k) (((MK_PHASE_MASK >> (k)) & 1) && lo <= (k) && (k) < hi)
#define BOTH(k) (IN(k) && IN((k) + 1))
#define REP(k) ((MK_REPEAT_PHASE == (k)) ? 2 : 1)
    bf16* U = (bf16*)F.out; bf16* Y0 = (bf16*)F.out; bf16* Y1 = (bf16*)((unsigned char*)F.out + ZBUF); float* R = F.out;
    bf16* MG = (bf16*)(ws + WS_MERGED); bf16* U2 = (bf16*)(ws + WS_U2); float* X1 = (float*)(ws + WS_X1); bf16* HB = (bf16*)(ws + WS_H);

    if (IN(0)) { for (int rep = 0; rep < REP(0); ++rep) { p0_prologue(F); __syncthreads(); } if (BOTH(0)) GRID_BAR(); }
    if (IN(1)) { for (int rep = 0; rep < REP(1); ++rep) p1_upass(F, U); if (BOTH(1)) GRID_BAR(); }
    if (IN(2)) {
        for (int rep = 0; rep < REP(2); ++rep) {
        pg8::Gemm g{U, F.Win_t, M, DIN, DM}; pg8::StaticOrder S; S.init(M, DIN, F.G, (int)blockIdx.x);
        pg8::EpiBf16<0> E{F.Z, 1024, nullptr, 1024, ZBUF / 2, 1.f};
        pg8::gemm_phase<pg8::EpiBf16<0>, pg8::StaticOrder, PG8_ALIGN, PG8_SP2>(F.lds + RING_OFF, g, S, E); }
        if (BOTH(2)) GRID_BAR();
    }
    if (IN(3)) { for (int rep = 0; rep < REP(3); ++rep) { p3_lru(F, Y0, Y1); __syncthreads(); } if (BOTH(3)) GRID_BAR(); }
    if (IN(4)) { for (int rep = 0; rep < REP(4); ++rep) { p4_attention(F, Y0, Y1, MG); __syncthreads(); } if (BOTH(4)) GRID_BAR(); }
    if (IN(5)) {
        for (int rep = 0; rep < REP(5); ++rep) {
        pg8::Gemm g{MG, F.Wout_t, M, DM, DM}; pg8::StaticOrder S; S.init(M, DM, F.G, (int)blockIdx.x);
        pg8::EpiRes E{F.x_p, F.x_s, R, nullptr, F.mod, MOD_G1, MP, ALPHA};
        pg8::gemm_phase<pg8::EpiRes, pg8::StaticOrder, PG8_ALIGN, PG8_SP2>(F.lds + RING_OFF, g, S, E); }
        if (BOTH(5)) GRID_BAR();
    }
    if (IN(6)) { for (int rep = 0; rep < REP(6); ++rep) ln_pass<true>(F, R, X1, U2, F.ln1_g, F.ln1_b); if (BOTH(6)) GRID_BAR(); }
    if (IN(7)) {
        for (int rep = 0; rep < REP(7); ++rep) {
        pg8::Gemm g{U2, F.Wup_t, M, FF, DM}; pg8::StaticOrder S; S.init(M, FF, F.G, (int)blockIdx.x);
        pg8::EpiBf16<2> E{HB, FF, F.b_up, 0, 0, 1.f};
        pg8::gemm_phase<pg8::EpiBf16<2>, pg8::StaticOrder, PG8_ALIGN, PG8_SP2>(F.lds + RING_OFF, g, S, E); }
        if (BOTH(7)) GRID_BAR();
    }
    if (IN(8)) {
        for (int rep = 0; rep < REP(8); ++rep) {
        pg8::Gemm g{HB, F.Wdn_t, M, DM, FF}; pg8::StaticOrder S; S.init(M, DM, F.G, (int)blockIdx.x);
        pg8::EpiRes E{X1, X1 + (size_t)MP * 1024, R, F.b_down, F.mod, MOD_G2, MP, ALPHA};
        pg8::gemm_phase<pg8::EpiRes, pg8::StaticOrder, PG8_ALIGN, PG8_SP2>(F.lds + RING_OFF, g, S, E); }
        if (BOTH(8)) GRID_BAR();
    }
    if (IN(9)) { ln_pass<false>(F, R, R, nullptr, F.ln2_g, F.ln2_b); }
#undef IN
#undef BOTH
#undef REP
}

extern "C" void kernel_launch(void* const* d_in, const int* in_sizes, int n_in, void* d_out, int out_size, void* d_ws, size_t ws_size, hipStream_t stream) {
    static int grid = 0;
    if (grid == 0) {
        if (n_in != 28 || in_sizes[0] != MP * DM || in_sizes[1] != MS * DM || (size_t)out_size != OUT_TOTAL || ws_size < WS_END) {
            fprintf(stderr, "kernel_launch: built for 28 inputs, x_prompt %d, out %zu floats, >= %zu bytes of workspace; got n_in %d, in0 %d, out %d, ws %zu; nothing launched\n", MP * DM, (size_t)OUT_TOTAL, (size_t)WS_END, n_in, n_in > 0 ? in_sizes[0] : -1, out_size, ws_size); grid = -1; return; }
        int dev = 0, cus = 0, per_cu = 0;
        if (hipGetDevice(&dev) != hipSuccess || hipDeviceGetAttribute(&cus, hipDeviceAttributeMultiprocessorCount, dev) != hipSuccess) { fprintf(stderr, "kernel_launch: hipGetDevice / hipDeviceGetAttribute failed\n"); grid = -1; return; }
        if (hipFuncSetAttribute((const void*)mega_fwd, hipFuncAttributeMaxDynamicSharedMemorySize, LDS_BYTES) != hipSuccess) { fprintf(stderr, "kernel_launch: hipFuncSetAttribute(%d B LDS) failed\n", LDS_BYTES); grid = -1; return; }
        if (hipOccupancyMaxActiveBlocksPerMultiprocessor(&per_cu, (const void*)mega_fwd, NWAVES * 64, LDS_BYTES) != hipSuccess || per_cu < 1)
            fprintf(stderr, "kernel_launch: note: occupancy query reports %d workgroups per CU\n", per_cu);
        (void)hipGetLastError();
        grid = cus;
        if (grid != 256) { fprintf(stderr, "kernel_launch: this kernel is built for a 256-CU device (got %d)\n", grid); grid = -1; return; }
    }
    if (grid < 0) return;
    if (hipMemsetAsync((char*)d_ws + WS_CTL, 0, CTL_ZERO_BYTES, stream) != hipSuccess) { fprintf(stderr, "kernel_launch: hipMemsetAsync failed\n"); return; }
    Args a{};
    for (int i = 0; i < 28; ++i) a.in[i] = (const float*)d_in[i];
    a.out = (float*)d_out; a.ws = (unsigned char*)d_ws;
    for (int li = 0; li < N_LAUNCHES; ++li) {
        a.ph_lo = (N_LAUNCHES == 1) ? 0 : li; a.ph_hi = (N_LAUNCHES == 1) ? N_PHASES : li + 1; a.li = li;
        hipLaunchKernelGGL(mega_fwd, dim3(grid), dim3(NWAVES * 64), LDS_BYTES, stream, a);
        const hipError_t le = hipPeekAtLastError();
        if (le != hipSuccess) { fprintf(stderr, "kernel_launch: launch %d failed: %s\n", li, hipGetErrorName(le)); break; }
    }
}
```
